# Optimizing an MI355X kernel written in HIP

```python
import math
import jax, jax.numpy as jnp
from jax import lax
import numpy as np

D_MODEL = 1024
BATCH = 2
SEQ = 16384
DEPTH = 4

CTX_LEN = 256
GRID_W = 64
EPS = 1e-6
SSM_WIDTH = 512
SSM_GROUP = 16
SSM_GROUPS = SSM_WIDTH // SSM_GROUP
SSM_STATE = 64
DT_MIN = 0.001
DT_MAX = 0.1
RET_WIDTH = 512
RET_HEADS = 4
RET_HEAD_DIM = RET_WIDTH // RET_HEADS
RET_CHUNK = 128
ROPE_BASE = 10000.0
PEER_HEADS = 8
PEER_NKEYS = 128
PEER_EXPERTS = PEER_NKEYS * PEER_NKEYS
PEER_DKEY = 128
PEER_TOPK = 16
PEER_BLOCK = 128
IN_COLS = SSM_WIDTH + 4 * RET_WIDTH + 2 * D_MODEL
IN_SPLITS = (SSM_WIDTH, SSM_WIDTH + RET_WIDTH, SSM_WIDTH + 2 * RET_WIDTH,
             SSM_WIDTH + 3 * RET_WIDTH, SSM_WIDTH + 4 * RET_WIDTH,
             SSM_WIDTH + 4 * RET_WIDTH + D_MODEL)

kernel_name = "hybrid_s5_retention_peer_diffusion_trunk"


def _rmsnorm(x, g):
    xf = x.astype(jnp.float32)
    y = xf * lax.rsqrt(jnp.mean(xf * xf, axis=-1, keepdims=True) + EPS)
    return (y * g.astype(jnp.float32)).astype(x.dtype)


def _modulate(h, shift, scale):
    return h * (1.0 + scale) + shift


def _s5_discretise(lam_re, lam_im, log_dt):
    lam = lax.complex(lam_re.astype(jnp.float32), lam_im.astype(jnp.float32))
    dt = jnp.exp(log_dt.astype(jnp.float32))[:, None]
    lam_bar = jnp.exp(lam * dt)
    b_fac = (lam_bar - 1.0) / lam
    return lam_bar, b_fac


def _ssm_combine(e1, e2):
    a1, b1 = e1
    a2, b2 = e2
    return a1 * a2, a2 * b1 + b2


def _s5_scan(bu, lam_bar, b_fac, h0):
    b = bu * b_fac
    if h0 is not None:
        b = b.at[:, 0].add(lam_bar * h0)
    a = jnp.broadcast_to(lam_bar, b.shape)
    _, h = lax.associative_scan(_ssm_combine, (a, b), axis=1)
    return h


def _s5(u, uc, B_re, B_im, C_re, C_im, d_skip, lam_re_f, lam_im_f, log_dt_f,
        lam_re_b, lam_im_b, log_dt_b, with_ctx_out):
    f32 = jnp.float32
    b_in = lax.complex(B_re.astype(f32), B_im.astype(f32))
    c_out = lax.complex(C_re.astype(f32), C_im.astype(f32))
    d = d_skip.astype(f32).reshape(SSM_GROUPS, SSM_GROUP)

    def grouped(t):
        return t.astype(f32).reshape(t.shape[0], t.shape[1], SSM_GROUPS, SSM_GROUP)

    def drive(tg):
        return jnp.einsum('blgi,gpi->blgp', tg.astype(jnp.complex64), b_in)

    def readout(h, tg):
        y = jnp.einsum('blgp,gip->blgi', h, c_out).real + d * tg
        return y.reshape(y.shape[0], y.shape[1], SSM_WIDTH)

    fwd = _s5_discretise(lam_re_f, lam_im_f, log_dt_f)
    bwd = _s5_discretise(lam_re_b, lam_im_b, log_dt_b)
    flip = lambda t: jnp.flip(t, axis=1)
    ug, ucg = grouped(u), grouped(uc)
    bu, bu_c = drive(ug), drive(ucg)
    hc_f = _s5_scan(bu_c, *fwd, None)
    hc_b = flip(_s5_scan(flip(bu_c), *bwd, None))
    h_f = _s5_scan(bu, *fwd, hc_f[:, -1])
    h_b = flip(_s5_scan(flip(bu), *bwd, hc_b[:, 0]))
    y = readout(h_f + h_b, ug)
    yc = readout(hc_f + hc_b, ucg) if with_ctx_out else None
    return y, yc


def _rotate(t, cos, sin):
    t1, t2 = jnp.split(t, 2, axis=-1)
    return jnp.concatenate([t1 * cos - t2 * sin, t1 * sin + t2 * cos], axis=-1)


def _rope2d(t, cos_r, sin_r, cos_c, sin_c):
    tf = t.astype(jnp.float32)
    tr, tc = jnp.split(tf, 2, axis=-1)
    out = jnp.concatenate([_rotate(tr, cos_r, sin_r), _rotate(tc, cos_c, sin_c)], axis=-1)
    return out.astype(t.dtype)


def _heads(t):
    nb, l, _ = t.shape
    return t.reshape(nb, l, RET_HEADS, RET_HEAD_DIM).transpose(0, 2, 1, 3)


def _retention_dir(q, k, v, log_gamma, state0, strict, with_out):
    f32 = jnp.float32
    nb, nh, l, dh = q.shape
    nc = l // RET_CHUNK
    blk = lambda t: t.astype(f32).reshape(nb, nh, nc, RET_CHUNK, dh)
    qb, kb, vb = blk(q), blk(k), blk(v)
    pos = jnp.arange(RET_CHUNK, dtype=f32)
    lg = log_gamma[:, None]
    k_decay = jnp.exp((RET_CHUNK - 1.0 - pos)[None] * lg)
    kv = jnp.einsum('bhncd,bhnce,hc->bhnde', kb, vb, k_decay)
    chunk_decay = jnp.exp(RET_CHUNK * log_gamma)[None, :, None, None]

    def step(s, kv_n):
        return chunk_decay * s + kv_n, s

    final, s_before = lax.scan(step, state0, jnp.moveaxis(kv, 2, 0))
    if not with_out:
        return None, final
    s_before = jnp.moveaxis(s_before, 0, 2)
    diff = pos[:, None] - pos[None, :]
    mask = diff > 0 if strict else diff >= 0
    dmat = jnp.where(mask[None], jnp.exp(jnp.where(mask, diff, 0.0)[None] * log_gamma[:, None, None]), 0.0)
    scores = jnp.einsum('bhncd,bhnmd->bhncm', qb, kb) * dmat[None, :, None]
    inner = jnp.einsum('bhncm,bhnme->bhnce', scores, vb)
    q_decay = jnp.exp((pos + 1.0)[None] * lg)
    cross = jnp.einsum('bhncd,bhnde,hc->bhnce', qb, s_before, q_decay)
    return (inner + cross).reshape(nb, nh, l, dh), final


def _retention(q, k, v, qc, kc, vc, lg_f, lg_b, with_ctx_out):
    nb, nh, _, dh = q.shape
    zero = jnp.zeros((nb, nh, dh, dh), jnp.float32)
    flip = lambda t: jnp.flip(t, axis=2)
    oc_f, sc_f = _retention_dir(qc, kc, vc, lg_f, zero, False, with_ctx_out)
    oc_b, sc_b = _retention_dir(flip(qc), flip(kc), flip(vc), lg_b, zero, True, with_ctx_out)
    o_f, _ = _retention_dir(q, k, v, lg_f, sc_f, False, True)
    o_b, _ = _retention_dir(flip(q), flip(k), flip(v), lg_b, sc_b, True, True)
    o = o_f + flip(o_b)
    oc = oc_f + flip(oc_b) if with_ctx_out else None
    return o, oc


def _ret_out(o, g):
    nb, nh, l, dh = o.shape
    of = o.transpose(0, 2, 1, 3)
    of = of * lax.rsqrt(jnp.mean(of * of, axis=-1, keepdims=True) + EPS)
    return of.reshape(nb, l, nh * dh).astype(g.dtype) * jax.nn.silu(g)


def _merge(y_s, y_r, gate_s, gate_r, w_ssm_glu, w_ret_up, w_out):
    a, b = jnp.split(jax.nn.gelu(y_s) @ w_ssm_glu, 2, axis=-1)
    ys = a * jax.nn.sigmoid(b)
    yr = y_r @ w_ret_up
    m = jax.nn.sigmoid(gate_s) * ys + jax.nn.sigmoid(gate_r) * yr
    return m @ w_out


def _mixer(h, hc, rope, w_in, B_re, B_im, C_re, C_im, d_skip, lam_re_f, lam_im_f, log_dt_f,
           lam_re_b, lam_im_b, log_dt_b, w_ssm_glu, ret_decay_f, ret_decay_b, w_ret_up, w_out,
           with_ctx_out):
    u, q, k, v, g, gs, gr = jnp.split(h @ w_in, IN_SPLITS, axis=-1)
    uc, qc, kc, vc, gc, gsc, grc = jnp.split(hc @ w_in, IN_SPLITS, axis=-1)
    ys, ysc = _s5(u, uc, B_re, B_im, C_re, C_im, d_skip, lam_re_f, lam_im_f, log_dt_f,
                  lam_re_b, lam_im_b, log_dt_b, with_ctx_out)
    k_scale = RET_HEAD_DIM ** -0.5
    q_h = _rope2d(_heads(q), *rope)
    k_h = _rope2d(_heads(k), *rope) * k_scale
    qc_h, kc_h = _heads(qc), _heads(kc) * k_scale
    lg_f = -jnp.exp(ret_decay_f.astype(jnp.float32))
    lg_b = -jnp.exp(ret_decay_b.astype(jnp.float32))
    o, oc = _retention(q_h, k_h, _heads(v), qc_h, kc_h, _heads(vc), lg_f, lg_b, with_ctx_out)
    y = _merge(ys.astype(h.dtype), _ret_out(o, g), gs, gr, w_ssm_glu, w_ret_up, w_out)
    if not with_ctx_out:
        return y, None
    yc = _merge(ysc.astype(hc.dtype), _ret_out(oc, gc), gsc, grc, w_ssm_glu, w_ret_up, w_out)
    return y, yc


def _peer(h, w_q, sub_keys, expert_u, expert_v):
    shape = h.shape
    tokens = h.reshape(-1, D_MODEL)
    n_blocks = tokens.shape[0] // PEER_BLOCK
    half = PEER_DKEY // 2

    def block(tb):
        t = tb.shape[0]
        qr = (tb @ w_q).reshape(t, PEER_HEADS, 2, half)
        s = jnp.einsum('thsk,hsnk->thsn', qr, sub_keys).astype(jnp.float32)
        top_s, top_i = lax.top_k(s, PEER_TOPK)
        cand_s = top_s[:, :, 0, :, None] + top_s[:, :, 1, None, :]
        cand_i = top_i[:, :, 0, :, None] * PEER_NKEYS + top_i[:, :, 1, None, :]
        best_s, best_j = lax.top_k(cand_s.reshape(t, PEER_HEADS, PEER_TOPK * PEER_TOPK), PEER_TOPK)
        idx = jnp.take_along_axis(cand_i.reshape(t, PEER_HEADS, PEER_TOPK * PEER_TOPK), best_j, axis=-1)
        gate = jax.nn.softmax(best_s, axis=-1)
        act = jax.nn.gelu(jnp.einsum('td,thkd->thk', tb, expert_u[idx]).astype(jnp.float32),
                          approximate=False)
        w = (gate * act).astype(tb.dtype)
        return jnp.einsum('thk,thkd->td', w, expert_v[idx])

    out = lax.map(block, tokens.reshape(n_blocks, PEER_BLOCK, D_MODEL))
    return out.reshape(shape)


def setup_inputs(seed: int = 0) -> dict:
    key = jax.random.key(seed)
    ks = iter(jax.random.split(key, 40))
    nrm = lambda shape, s: jax.random.normal(next(ks), shape, jnp.float32) * s
    G, P, I, H = SSM_GROUPS, SSM_STATE, SSM_GROUP, RET_HEADS
    lam_im0 = math.pi * jnp.arange(P, dtype=jnp.float32)
    ret0 = jnp.log(-jnp.log(1.0 - 2.0 ** (-5.0 - jnp.arange(H, dtype=jnp.float32))))
    log_dt = lambda: jax.random.uniform(next(ks), (DEPTH, G), jnp.float32,
                                        math.log(DT_MIN), math.log(DT_MAX))
    return {
        "x": nrm((BATCH, SEQ, D_MODEL), 1.0),
        "c": nrm((BATCH, D_MODEL), 1.0),
        "ctx": nrm((BATCH, CTX_LEN, D_MODEL), 1.0),
        "c_ctx": nrm((D_MODEL,), 1.0),
        "w_mod": nrm((DEPTH, D_MODEL, 6 * D_MODEL), 0.5 * D_MODEL ** -0.5),
        "b_mod": nrm((DEPTH, 6 * D_MODEL), 0.02),
        "norm1_g": 1.0 + nrm((DEPTH, D_MODEL), 0.02),
        "norm2_g": 1.0 + nrm((DEPTH, D_MODEL), 0.02),
        "w_in": nrm((DEPTH, D_MODEL, IN_COLS), D_MODEL ** -0.5),
        "ssm_B_re": nrm((DEPTH, G, P, I), (2.0 * I) ** -0.5),
        "ssm_B_im": nrm((DEPTH, G, P, I), (2.0 * I) ** -0.5),
        "ssm_C_re": nrm((DEPTH, G, I, P), 0.5),
        "ssm_C_im": nrm((DEPTH, G, I, P), 0.5),
        "ssm_D": nrm((DEPTH, SSM_WIDTH), 1.0),
        "ssm_lam_re_f": -0.5 + nrm((DEPTH, G, P), 0.01),
        "ssm_lam_im_f": lam_im0 + nrm((DEPTH, G, P), 0.01),
        "ssm_log_dt_f": log_dt(),
        "ssm_lam_re_b": -0.5 + nrm((DEPTH, G, P), 0.01),
        "ssm_lam_im_b": lam_im0 + nrm((DEPTH, G, P), 0.01),
        "ssm_log_dt_b": log_dt(),
        "w_ssm_glu": nrm((DEPTH, SSM_WIDTH, 2 * D_MODEL), SSM_WIDTH ** -0.5),
        "ret_decay_f": ret0 + nrm((DEPTH, H), 0.05),
        "ret_decay_b": ret0 + nrm((DEPTH, H), 0.05),
        "w_ret_up": nrm((DEPTH, RET_WIDTH, D_MODEL), RET_WIDTH ** -0.5),
        "w_out": nrm((DEPTH, D_MODEL, D_MODEL), D_MODEL ** -0.5),
        "peer_w_q": nrm((DEPTH, D_MODEL, PEER_HEADS * PEER_DKEY), D_MODEL ** -0.5),
        "peer_sub_keys": nrm((DEPTH, PEER_HEADS, 2, PEER_NKEYS, PEER_DKEY // 2), (PEER_DKEY // 2) ** -0.5),
        "peer_u": nrm((DEPTH, PEER_EXPERTS, D_MODEL), D_MODEL ** -0.5),
        "peer_v": nrm((DEPTH, PEER_EXPERTS, D_MODEL), 0.5),
        "final_norm_g": 1.0 + nrm((D_MODEL,), 0.02),
    }


def reference(x, c, ctx, c_ctx, w_mod, b_mod, norm1_g, norm2_g, w_in, ssm_B_re, ssm_B_im,
              ssm_C_re, ssm_C_im, ssm_D, ssm_lam_re_f, ssm_lam_im_f, ssm_log_dt_f,
              ssm_lam_re_b, ssm_lam_im_b, ssm_log_dt_b, w_ssm_glu, ret_decay_f, ret_decay_b,
              w_ret_up, w_out, peer_w_q, peer_sub_keys, peer_u, peer_v, final_norm_g):
    seq = x.shape[1]
    rows = seq // GRID_W
    row_ids = jnp.repeat(jnp.arange(rows, dtype=jnp.float32), GRID_W)
    col_ids = jnp.tile(jnp.arange(GRID_W, dtype=jnp.float32), rows)
    n_freq = RET_HEAD_DIM // 4
    freqs = ROPE_BASE ** (-jnp.arange(n_freq, dtype=jnp.float32) / n_freq)
    ang_r = row_ids[:, None] * freqs[None]
    ang_c = col_ids[:, None] * freqs[None]
    rope = (jnp.cos(ang_r), jnp.sin(ang_r), jnp.cos(ang_c), jnp.sin(ang_c))

    xc = ctx
    for i in range(DEPTH):
        last = i == DEPTH - 1
        mod = jax.nn.silu(c) @ w_mod[i] + b_mod[i]
        mod_c = jax.nn.silu(c_ctx) @ w_mod[i] + b_mod[i]
        sh1, sc1, g1, sh2, sc2, g2 = jnp.split(mod[:, None, :], 6, axis=-1)
        sh1c, sc1c, g1c, sh2c, sc2c, g2c = jnp.split(mod_c, 6, axis=-1)
        h = _modulate(_rmsnorm(x, norm1_g[i]), sh1, sc1)
        hc = _modulate(_rmsnorm(xc, norm1_g[i]), sh1c, sc1c)
        y, yc = _mixer(h, hc, rope, w_in[i], ssm_B_re[i], ssm_B_im[i], ssm_C_re[i], ssm_C_im[i],
                       ssm_D[i], ssm_lam_re_f[i], ssm_lam_im_f[i], ssm_log_dt_f[i],
                       ssm_lam_re_b[i], ssm_lam_im_b[i], ssm_log_dt_b[i], w_ssm_glu[i],
                       ret_decay_f[i], ret_decay_b[i], w_ret_up[i], w_out[i], not last)
        x = x + g1 * y
        h2 = _modulate(_rmsnorm(x, norm2_g[i]), sh2, sc2)
        x = x + g2 * _peer(h2, peer_w_q[i], peer_sub_keys[i], peer_u[i], peer_v[i])
        if not last:
            xc = xc + g1c * yc
            hc2 = _modulate(_rmsnorm(xc, norm2_g[i]), sh2c, sc2c)
            xc = xc + g2c * _peer(hc2, peer_w_q[i], peer_sub_keys[i], peer_u[i], peer_v[i])
    return _rmsnorm(x, final_norm_g)
```

```cpp
#include <hip/hip_runtime.h>
#include <stdint.h>
#include <stdio.h>

#define ENABLE_PEER 1

#define LAS __attribute__((address_space(3)))
typedef unsigned short bf16_t;
typedef short bf16x8 __attribute__((ext_vector_type(8)));
typedef float f32x4 __attribute__((ext_vector_type(4)));
typedef __bf16 bf16x2 __attribute__((ext_vector_type(2)));
typedef unsigned u32x4 __attribute__((ext_vector_type(4)));
typedef unsigned u32x2 __attribute__((ext_vector_type(2)));
typedef float f32x2 __attribute__((ext_vector_type(2)));

constexpr int D = 1024, NB = 2, SEQ = 16384, CTX = 256, DEPTH = 4;
constexpr int ML = NB * SEQ, MC = NB * CTX, M = ML + MC;
constexpr int TS = SEQ + CTX;
constexpr int INC = 4608;
constexpr int NEXP = 16384;
constexpr float EPS = 1e-6f;
constexpr int NT = 512;

enum { I_X = 0, I_C, I_CTX, I_CCTX, I_WMOD, I_BMOD, I_N1G, I_N2G, I_WIN, I_BRE, I_BIM, I_CRE, I_CIM, I_SSMD, I_LREF, I_LIMF, I_LDTF,
       I_LREB, I_LIMB, I_LDTB, I_WGLU, I_RDF, I_RDB, I_WRU, I_WOUT, I_WQ, I_SKEY, I_PU, I_PV, I_FNG };

struct Params { const float* in[30]; float* out; unsigned char* ws; };
#define AS4 __attribute__((address_space(4)))
struct Ctx {
    const AS4 unsigned long long* ka;
    __device__ __forceinline__ const float* in(int i) const { return (const float*)(const __attribute__((address_space(1))) float*)ka[i]; }
    __device__ __forceinline__ float* out() const { return (float*)(__attribute__((address_space(1))) float*)ka[30]; }
    __device__ __forceinline__ unsigned char* ws() const { return (unsigned char*)(__attribute__((address_space(1))) unsigned char*)ka[31]; }
};
__device__ __forceinline__ unsigned char* wsw(const Ctx& p, int l);
__device__ __forceinline__ Ctx get_ctx() {
    const AS4 unsigned long long* ka = (const AS4 unsigned long long*)__builtin_amdgcn_kernarg_segment_ptr();
    asm volatile("" : "+s"(ka));
    return Ctx{ka};
}

constexpr size_t al(size_t x) { return (x + 4095) & ~(size_t)4095; }
constexpr size_t OFF_BAR   = 0;
constexpr size_t OFF_MODV  = 16384;
constexpr size_t OFF_ROPE  = al(OFF_MODV + (size_t)4 * 3 * 6144 * 4);
constexpr size_t OFF_S5AT  = al(OFF_ROPE + (size_t)(256 * 32 * 2 + 64 * 32 * 2) * 4);
constexpr size_t OFF_SCU   = al(OFF_S5AT + (size_t)32 * 2 * 64 * 2 * 4);
constexpr size_t OFF_SCV   = al(OFF_SCU + (size_t)NEXP * 4);
constexpr size_t OFF_WINT  = al(OFF_SCV + (size_t)NEXP * 4);
constexpr size_t OFF_WGLUT = al(OFF_WINT + (size_t)INC * D * 2);
constexpr size_t OFF_WRUT  = al(OFF_WGLUT + (size_t)2048 * 512 * 2);
constexpr size_t OFF_WOUTT = al(OFF_WRUT + (size_t)1024 * 512 * 2);
constexpr size_t OFF_WQT   = al(OFF_WOUTT + (size_t)D * D * 2);
constexpr size_t OFF_SKEY  = al(OFF_WQT + (size_t)D * D * 2);
constexpr size_t OFF_PU    = al(OFF_SKEY + (size_t)16 * 128 * 64 * 2);
constexpr size_t OFF_PV    = al(OFF_PU + (size_t)NEXP * D);
constexpr size_t OFF_S5W   = al(OFF_PV + (size_t)NEXP * D);
constexpr size_t OFF_S5TV  = al(OFF_S5W + (size_t)32 * 256 * 512 * 2);
constexpr size_t WBLK      = al(OFF_S5TV + (size_t)32 * 512 * 768 * 2) - OFF_S5AT;
constexpr size_t OFF_XC    = OFF_S5AT + 2 * WBLK;
constexpr size_t OFF_H     = al(OFF_XC + (size_t)MC * D * 4);
constexpr size_t OFF_U     = al(OFF_H + (size_t)M * D * 2);
constexpr size_t OFF_Q     = al(OFF_U + (size_t)M * 512 * 2);
constexpr size_t OFF_K     = al(OFF_Q + (size_t)M * 512 * 2);
constexpr size_t OFF_G     = al(OFF_K + (size_t)M * 512 * 2);
constexpr size_t OFF_KTF   = al(OFF_G + (size_t)M * 512 * 2);
constexpr size_t OFF_KTB   = al(OFF_KTF + (size_t)NB * 4 * 128 * TS * 2);
constexpr size_t OFF_VT    = al(OFF_KTB + (size_t)NB * 4 * 128 * TS * 2);
constexpr size_t OFF_GS    = al(OFF_VT + (size_t)NB * 4 * 128 * TS * 2);
constexpr size_t OFF_GR    = al(OFF_GS + (size_t)M * D * 2);
constexpr size_t OFF_SBUF  = al(OFF_GR + (size_t)M * D * 2);
constexpr size_t OFF_HIN   = al(OFF_SBUF + (size_t)32 * 1040 * 256 * 4);
constexpr size_t OFF_YS    = al(OFF_HIN + (size_t)32 * 1040 * 256 * 2);
constexpr size_t OFF_KV    = al(OFF_YS + (size_t)M * 512 * 2);
constexpr size_t OFF_SBEF  = al(OFF_KV + (size_t)NB * 4 * 2 * 130 * 16384 * 2);
constexpr size_t OFF_YR    = al(OFF_SBEF + (size_t)NB * 4 * 2 * 130 * 16384 * 2);
constexpr size_t OFF_PBUF  = al(OFF_YR + (size_t)M * 512 * 2);
constexpr size_t OFF_AS5   = al(OFF_PBUF + (size_t)256 * 128 * 128 * 2);
constexpr size_t WS_TOTAL  = al(OFF_AS5 + (size_t)32 * 1040 * 768 * 2);
constexpr size_t OFF_QP    = OFF_GS;
constexpr size_t OFF_IDX   = OFF_GR;
constexpr size_t OFF_GATE  = OFF_GR + (size_t)M * 128 * 4;

__device__ __forceinline__ unsigned char* wsw(const Ctx& p, int l) { return p.ws() + (size_t)(l & 1) * WBLK; }
__device__ __forceinline__ float bf2f(unsigned short u) { return __uint_as_float(((unsigned)u) << 16); }
__device__ __forceinline__ unsigned pack_bf16(float lo, float hi) { bf16x2 v; v[0] = (__bf16)lo; v[1] = (__bf16)hi; return __builtin_bit_cast(unsigned, v); }
__device__ __forceinline__ float wave_sum(float v) {
#pragma unroll
    for (int o = 32; o > 0; o >>= 1) v += __shfl_xor(v, o);
    return v;
}
__device__ __forceinline__ float rcp_f(float v) { return __builtin_amdgcn_rcpf(v); }
__device__ __forceinline__ float silu_f(float v) { return v * rcp_f(1.f + __expf(-v)); }
__device__ __forceinline__ float sigmoid_f(float v) { return rcp_f(1.f + __expf(-v)); }
__device__ __forceinline__ float gelu_tanh_f(float v) { const float u = 0.7978845608028654f * (v + 0.044715f * v * v * v); return v * rcp_f(1.f + __expf(-2.f * u)); }
__device__ __forceinline__ float gelu_erf_f(float v) { return 0.5f * v * (1.f + erff(v * 0.7071067811865476f)); }
__device__ __forceinline__ float dot2bf(unsigned a, unsigned b, float c) { return __builtin_amdgcn_fdot2_f32_bf16(__builtin_bit_cast(bf16x2, a), __builtin_bit_cast(bf16x2, b), c, false); }
__device__ __forceinline__ int tid_opaque() { int t = threadIdx.x; asm volatile("" : "+v"(t)); return t; }
__device__ __forceinline__ int mod_index(int row) { return row < ML ? (row >> 14) : 2; }

#define XB_TMO      128
#define XB_XCNT(j)  (256  + 64 * (j))
#define XB_XSUB(j)  (1280 + 64 * (j))
#define XB_XGEN(j)  (2304 + 64 * (j))
#define XB_TOP      3328
#define XB_TOPGEN   3392
#define XCD_BAR_WORDS 3456
#define XB_SPIN_CAP (1u << 18)

typedef __attribute__((address_space(1))) unsigned gu32;
__device__ __forceinline__ unsigned xb_ld(unsigned* p)              { return __hip_atomic_load((gu32*)p, __ATOMIC_RELAXED, __HIP_MEMORY_SCOPE_AGENT); }
__device__ __forceinline__ unsigned xb_add(unsigned* p, unsigned v) { return __hip_atomic_fetch_add((gu32*)p, v, __ATOMIC_RELAXED, __HIP_MEMORY_SCOPE_AGENT); }
__device__ __forceinline__ unsigned xb_xcc_id() { return (unsigned)__builtin_amdgcn_s_getreg((3 << 11) | 20) & 0xFu; }
#define XB_SPIN(cond, bar) do { unsigned _sp = 0; while (cond) { __builtin_amdgcn_s_sleep(1); \
    if ((++_sp & 255u) == 0u) { if (xb_ld(&(bar)[XB_TMO])) break; if (_sp > XB_SPIN_CAP) { atomicAdd(&(bar)[XB_TMO], 1u); break; } } } } while (0)

struct XcdBarrier { unsigned* bar; unsigned x; volatile LAS unsigned* st; };

__device__ __forceinline__ XcdBarrier xcd_barrier_post(unsigned* bar, volatile LAS unsigned* st) {
    XcdBarrier b; b.bar = bar; b.x = xb_xcc_id(); b.st = st;
    if (threadIdx.x == 0) (void)xb_add(&bar[XB_XCNT(b.x)], 1u);
    return b;
}
__device__ __forceinline__ void xcd_barrier_complete(unsigned* bar, unsigned x, unsigned& nloc, unsigned& nx) {
    const unsigned G = gridDim.x * gridDim.y * gridDim.z;
    unsigned sum, cnt, mine, sp = 0u;
    for (;;) {
        sum = 0u; cnt = 0u; mine = 0u;
#pragma unroll
        for (unsigned j = 0; j < 16; ++j) { const unsigned c = xb_ld(&bar[XB_XCNT(j)]); sum += c; cnt += (c > 0u) ? 1u : 0u; mine = (j == x) ? c : mine; }
        if (sum == G) break;
        __builtin_amdgcn_s_sleep(1);
        if ((++sp & 255u) == 0u) { if (xb_ld(&bar[XB_TMO])) break; if (sp > XB_SPIN_CAP) { atomicAdd(&bar[XB_TMO], 1u); break; } }
    }
    nloc = mine > 0u ? mine : 1u; nx = cnt > 0u ? cnt : 1u;
}
__device__ __forceinline__ void xcd_barrier(const XcdBarrier& b) {
    asm volatile("s_waitcnt vmcnt(0)" ::: "memory");
    __syncthreads();
    if (threadIdx.x == 0) {
        unsigned* bar = b.bar;
        __builtin_amdgcn_s_waitcnt(0);
        unsigned nloc = b.st[0], nx = b.st[1];
        if (nloc == 0u) { xcd_barrier_complete(bar, b.x, nloc, nx); b.st[0] = nloc; b.st[1] = nx; }
        const unsigned old = xb_add(&bar[XB_XSUB(b.x)], 1u);
        const unsigned gen = old / nloc;
        if (old + 1u == (gen + 1u) * nloc) {
            __builtin_amdgcn_fence(__ATOMIC_RELEASE, "agent");
            asm volatile("s_waitcnt vmcnt(0)" ::: "memory");
            const unsigned og = xb_add(&bar[XB_TOP], 1u);
            const unsigned tg = og / nx;
            if (og + 1u == (tg + 1u) * nx) xb_add(&bar[XB_TOPGEN], 1u);
            else XB_SPIN(xb_ld(&bar[XB_TOPGEN]) == tg, bar);
            __builtin_amdgcn_fence(__ATOMIC_ACQUIRE, "agent");
            xb_add(&bar[XB_XGEN(b.x)], 1u);
            asm volatile("s_waitcnt vmcnt(0)" ::: "memory");
        } else {
            XB_SPIN(xb_ld(&bar[XB_XGEN(b.x)]) == gen, bar);
            __builtin_amdgcn_fence(__ATOMIC_ACQUIRE, "agent");
            asm volatile("s_waitcnt vmcnt(0)" ::: "memory");
        }
    }
    __syncthreads();
}


#define GS_CNT(j) (3520 + 64 * ((j) & 7))
#ifndef SOFT_SYNC
#define SOFT_SYNC 1
#endif
__device__ __forceinline__ void xcd_soft_sync(unsigned* bar, volatile LAS unsigned* st, unsigned step) {
#if SOFT_SYNC
    if (threadIdx.x == 0) {
        const unsigned x = xb_xcc_id(), nloc = st[0];
        if (nloc != 0u) {
            const unsigned target = nloc * (step + 1u);
            (void)xb_add(&bar[GS_CNT(x)], 1u);
            for (int sp = 0; sp < 4000; ++sp) { if (xb_ld(&bar[GS_CNT(x)]) >= target) break; __builtin_amdgcn_s_sleep(2); }
        }
    }
    __syncthreads();
#endif
}
constexpr int LROW = 72;
constexpr int TILE_LDS = 128 * LROW * 2;
constexpr int MMA_LDS = 4 * TILE_LDS;
constexpr int LDS_BYTES = 147456;
constexpr int XB_LDS_OFF = LDS_BYTES - 16;
constexpr int PP = 136;
constexpr int P_LDS_OFF = MMA_LDS;
constexpr int RED_LDS_OFF = P_LDS_OFF + 128 * PP * 2;

template <bool SW, bool ALDS, class LA, class LB>
__device__ __forceinline__ void mma_tile_g(f32x4 (&acc)[4][2], const LA& la, const LB& lb, const int K, LAS unsigned char* lds) {
    const int tid = tid_opaque(), lane = tid & 63, wid = __builtin_amdgcn_readfirstlane(tid >> 6), wm = wid >> 2, wn = wid & 3;
    const int lr = tid >> 3, lk = (tid & 7) * 8;
    const int nkt = K >> 6;
    u32x4 ra0, ra1, rb0, rb1;
    if (!ALDS) { ra0 = *(const u32x4*)la(lr, lk); ra1 = *(const u32x4*)la(lr + 64, lk); }
    rb0 = *(const u32x4*)lb(lr, lk); rb1 = *(const u32x4*)lb(lr + 64, lk);
    const int woff = (lr * LROW + lk) * 2;
    {
        LAS unsigned char* Ab = lds; LAS unsigned char* Bb = lds + TILE_LDS;
        if (!ALDS) { *(LAS u32x4*)(Ab + woff) = ra0; *(LAS u32x4*)(Ab + woff + 64 * LROW * 2) = ra1; }
        *(LAS u32x4*)(Bb + woff) = rb0; *(LAS u32x4*)(Bb + woff + 64 * LROW * 2) = rb1;
    }
    __syncthreads();
    const int aoff = ALDS ? P_LDS_OFF + ((wm * 64 + (lane & 15)) * PP + (lane >> 4) * 8) * 2 : ((wm * 64 + (lane & 15)) * LROW + (lane >> 4) * 8) * 2;
    const int boff = ((wn * 32 + (lane & 15)) * LROW + (lane >> 4) * 8) * 2;
    for (int kt = 0; kt < nkt; ++kt) {
        const bool more = (kt + 1 < nkt);
        if (more) {
            const int k = (kt + 1) * 64 + lk;
            if (!ALDS) { ra0 = *(const u32x4*)la(lr, k); ra1 = *(const u32x4*)la(lr + 64, k); }
            rb0 = *(const u32x4*)lb(lr, k); rb1 = *(const u32x4*)lb(lr + 64, k);
        }
        LAS unsigned char* Ab = lds + (kt & 1) * 2 * TILE_LDS; LAS unsigned char* Bb = Ab + TILE_LDS;
#pragma unroll
        for (int ks = 0; ks < 2; ++ks) {
            bf16x8 af[4], bfr[2];
#pragma unroll
            for (int mt = 0; mt < 4; ++mt)
                af[mt] = ALDS ? *(const LAS bf16x8*)(lds + aoff + (mt * 16 * PP + kt * 64 + ks * 32) * 2)
                              : *(const LAS bf16x8*)(Ab + aoff + (mt * 16 * LROW + ks * 32) * 2);
#pragma unroll
            for (int nt = 0; nt < 2; ++nt) bfr[nt] = *(const LAS bf16x8*)(Bb + boff + (nt * 16 * LROW + ks * 32) * 2);
#pragma unroll
            for (int mt = 0; mt < 4; ++mt)
#pragma unroll
                for (int nt = 0; nt < 2; ++nt)
                    acc[mt][nt] = SW ? __builtin_amdgcn_mfma_f32_16x16x32_bf16(bfr[nt], af[mt], acc[mt][nt], 0, 0, 0)
                                     : __builtin_amdgcn_mfma_f32_16x16x32_bf16(af[mt], bfr[nt], acc[mt][nt], 0, 0, 0);
        }
        if (more) {
            LAS unsigned char* An = lds + ((kt + 1) & 1) * 2 * TILE_LDS; LAS unsigned char* Bn = An + TILE_LDS;
            if (!ALDS) { *(LAS u32x4*)(An + woff) = ra0; *(LAS u32x4*)(An + woff + 64 * LROW * 2) = ra1; }
            *(LAS u32x4*)(Bn + woff) = rb0; *(LAS u32x4*)(Bn + woff + 64 * LROW * 2) = rb1;
        }
        __syncthreads();
    }
}
template <bool SW, class LA, class LB>
__device__ __forceinline__ void mma_tile(f32x4 (&acc)[4][2], const LA& la, const LB& lb, const int K, LAS unsigned char* lds) {
    mma_tile_g<SW, false>(acc, la, lb, K, lds);
}
__device__ __forceinline__ void zero_acc(f32x4 (&acc)[4][2]) {
#pragma unroll
    for (int a = 0; a < 4; ++a)
#pragma unroll
        for (int b = 0; b < 2; ++b) acc[a][b] = (f32x4){0.f, 0.f, 0.f, 0.f};
}
__device__ __forceinline__ void tile_coords(int id, int nMt, int nNt, int& mt, int& nt) {
    const int per = 16 * nNt, g = id / per, r = id % per, m0 = g * 16, gm = (nMt - m0) < 16 ? (nMt - m0) : 16;
    mt = m0 + r % gm; nt = r / gm;
}


namespace pg8 {
constexpr int BM = 256, BK = 64, HALF = 128, HTB = HALF * BK * 2, STAGE_BYTES = 8 * HTB, NXCD = 8, WGM = 4;
__device__ __forceinline__ int lds_byte(int r, int c) { const int st = (r >> 4) * 2 + (c >> 5), rr = r & 15, cc = c & 31, ob = rr * 64 + cc * 2; return st * 1024 + (ob ^ (((ob >> 9) & 1) << 5)); }
__device__ __forceinline__ void stage_rc(int b, int& R, int& C) { const int st = b / 1024, sb = b % 1024, swz = sb ^ (((sb >> 9) & 1) << 5); R = (st >> 1) * 16 + swz / 64; C = (st & 1) * 32 + (swz % 64) / 2; }
struct Unit { int pm, pn; };
struct Gemm { const bf16_t* A; const bf16_t* Bt; int M, N, K; };
struct StaticOrder {
    int nM, nN, nwg, G, c;
    __device__ void init(int M_, int N_, int G_, int c_) { nM = M_ / BM; nN = N_ / BM; nwg = nM * nN; G = G_; c = c_; }
    __device__ bool next(int i, Unit& u) const {
        const long L = (long)i * G + c; if (L >= nwg) return false;
        int wgid = (int)L; { const int q = nwg / NXCD, r = nwg % NXCD, xcd = wgid % NXCD, off = wgid / NXCD; wgid = (xcd < r ? xcd * (q + 1) : r * (q + 1) + (xcd - r) * q) + off; }
        const int nig = WGM * nN, gid = wgid / nig, fm = gid * WGM, gsz = (nM - fm) < WGM ? (nM - fm) : WGM;
        u.pm = fm + ((wgid % nig) % gsz); u.pn = (wgid % nig) / gsz; return true;
    }
    __device__ __forceinline__ const char* abase(const Gemm& g, const Unit& u) const { return (const char*)g.A + (size_t)u.pm * ((size_t)BM * g.K * 2); }
    __device__ __forceinline__ const char* bbase(const Gemm& g, const Unit& u) const { return (const char*)g.Bt + (size_t)u.pn * ((size_t)BM * g.K * 2); }
};
template <class Epi, class Sched>
__device__ __forceinline__ void gemm_phase(LAS unsigned char* lds, const Gemm g, const Sched& S, const Epi& E) {
    const int tid = tid_opaque(), wid = __builtin_amdgcn_readfirstlane(tid >> 6), lane = tid & 63, wr = wid >> 2, wc = wid & 3, fr = lane & 15, fq = lane >> 4;
    const int K = g.K, nt = K / BK;
    unsigned voffA[2], voffB[2];
#pragma unroll
    for (int i = 0; i < 2; ++i) { int R, C; stage_rc(tid * 16 + i * 8192, R, C); voffA[i] = (unsigned)(R * K + C) * 2u; voffB[i] = voffA[i]; }
    const size_t kstep = (size_t)(BK * 2);
    const size_t hstep = (size_t)HALF * K * 2;
    const unsigned ldsw = (unsigned)wid * 1024u;
    const int aoff = lds_byte(wr * 64 + fr, fq * 8), boff = lds_byte(wc * 32 + fr, fq * 8);
#define PG8_SA(b, h) (((b) * 2 + (h)) * HTB)
#define PG8_SB(b, h) ((4 + (b) * 2 + (h)) * HTB)
#define PG8_STAGE(bufoff, gbase, voff) do { _Pragma("unroll") for (int _i = 0; _i < 2; ++_i) \
        __builtin_amdgcn_global_load_lds((const unsigned*)((const char*)(gbase) + (voff)[_i]), (LAS unsigned*)(lds + (bufoff) + ldsw + _i * 8192), 16, 0, 0); } while (0)
#define PG8_LDA(dst, b, h) do { _Pragma("unroll") for (int m = 0; m < 4; ++m) _Pragma("unroll") for (int k = 0; k < 2; ++k) dst[m][k] = *(const LAS bf16x8*)(lds + PG8_SA(b, h) + aoff + m * 2048 + k * 1024); } while (0)
#define PG8_LDB(dst, b, h) do { _Pragma("unroll") for (int n = 0; n < 2; ++n) _Pragma("unroll") for (int k = 0; k < 2; ++k) dst[n][k] = *(const LAS bf16x8*)(lds + PG8_SB(b, h) + boff + n * 2048 + k * 1024); } while (0)
#define PG8_MMA(ai, bj, At, Bt) do { __builtin_amdgcn_s_setprio(1); _Pragma("unroll") for (int m = 0; m < 4; ++m) _Pragma("unroll") for (int n = 0; n < 2; ++n) _Pragma("unroll") for (int k = 0; k < 2; ++k) \
        acc[ai][bj][m][n] = __builtin_amdgcn_mfma_f32_16x16x32_bf16(Bt[n][k], At[m][k], acc[ai][bj][m][n], 0, 0, 0); __builtin_amdgcn_s_setprio(0); } while (0)
#define PG8_WAIT_V(n) asm volatile("s_waitcnt vmcnt(" #n ")" ::: "memory")
#define PG8_WAIT_L(n) asm volatile("s_waitcnt lgkmcnt(" #n ")" ::: "memory")
#define PG8_BAR __builtin_amdgcn_s_barrier()
#define PG8_SCHED __builtin_amdgcn_sched_barrier(0)
    Unit cur, nxt; int ui = 0;
    if (!S.next(0, cur)) return;
    f32x4 acc[2][2][4][2];
#pragma unroll
    for (int a = 0; a < 2; ++a)
#pragma unroll
        for (int b = 0; b < 2; ++b)
#pragma unroll
            for (int m = 0; m < 4; ++m)
#pragma unroll
                for (int n = 0; n < 2; ++n) acc[a][b][m][n] = (f32x4){0.f, 0.f, 0.f, 0.f};
    bf16x8 At[4][2], B0[2][2], B1[2][2];
    const char* cA = S.abase(g, cur); const char* cB = S.bbase(g, cur);
    PG8_STAGE(PG8_SB(0, 0), cB, voffB); PG8_STAGE(PG8_SA(0, 0), cA, voffA); PG8_STAGE(PG8_SB(0, 1), cB + hstep, voffB); PG8_STAGE(PG8_SA(0, 1), cA + hstep, voffA);
    if (wr == 1) PG8_BAR;
    PG8_WAIT_V(4); PG8_BAR;
    PG8_STAGE(PG8_SB(1, 0), cB + kstep, voffB); PG8_STAGE(PG8_SA(1, 0), cA + kstep, voffA); PG8_STAGE(PG8_SB(1, 1), cB + hstep + kstep, voffB);
    PG8_WAIT_V(6); PG8_BAR;
    for (;;) {
        const bool has_next = S.next(ui + 1, nxt);
        const char* nA = has_next ? S.abase(g, nxt) : cA; const char* nB = has_next ? S.bbase(g, nxt) : cB;
        for (int t = 0; t < nt; t += 2) {
            const bool last = (t == nt - 2);
            const char* a1 = cA + (size_t)(t + 1) * kstep;
            const char* a2 = last ? nA : cA + (size_t)(t + 2) * kstep; const char* b2 = last ? nB : cB + (size_t)(t + 2) * kstep;
            const char* a3 = a2 + kstep; const char* b3 = b2 + kstep;
            PG8_LDB(B0, 0, 0); PG8_SCHED; PG8_LDA(At, 0, 0); PG8_STAGE(PG8_SA(1, 1), a1 + hstep, voffA);
            PG8_WAIT_L(8); PG8_BAR; PG8_WAIT_L(0); PG8_MMA(0, 0, At, B0); PG8_BAR; PG8_SCHED;
            PG8_LDB(B1, 0, 1); PG8_STAGE(PG8_SB(0, 0), b2, voffB);
            PG8_BAR; PG8_WAIT_L(0); PG8_MMA(0, 1, At, B1); PG8_BAR;
            PG8_LDA(At, 0, 1); PG8_STAGE(PG8_SA(0, 0), a2, voffA);
            PG8_BAR; PG8_WAIT_L(0); PG8_MMA(1, 0, At, B0); PG8_BAR; PG8_SCHED;
            PG8_STAGE(PG8_SB(0, 1), b2 + hstep, voffB);
            PG8_WAIT_V(6); PG8_BAR; PG8_MMA(1, 1, At, B1); PG8_BAR;
            PG8_LDB(B0, 1, 0); PG8_SCHED; PG8_LDA(At, 1, 0); PG8_STAGE(PG8_SA(0, 1), a2 + hstep, voffA);
            PG8_WAIT_L(8); PG8_BAR; PG8_WAIT_L(0); PG8_MMA(0, 0, At, B0); PG8_BAR; PG8_SCHED;
            PG8_LDB(B1, 1, 1); PG8_STAGE(PG8_SB(1, 0), b3, voffB);
            PG8_BAR; PG8_WAIT_L(0); PG8_MMA(0, 1, At, B1); PG8_BAR;
            PG8_LDA(At, 1, 1); PG8_STAGE(PG8_SA(1, 0), a3, voffA);
            PG8_BAR; PG8_WAIT_L(0); PG8_MMA(1, 0, At, B0); PG8_BAR; PG8_SCHED;
            PG8_STAGE(PG8_SB(1, 1), b3 + hstep, voffB);
            PG8_WAIT_V(6); PG8_BAR; PG8_MMA(1, 1, At, B1); PG8_BAR;
        }
#pragma unroll
        for (int ai = 0; ai < 2; ++ai) {
            if constexpr (Epi::PAIR) {
                typename Epi::Pre pre[2];
#pragma unroll
                for (int bj = 0; bj < 2; ++bj) E.template prefetch<4>(pre[bj], (cur.pm * 2 + ai) * 128 + wr * 64, cur.pn * 2 + bj, wc, lane);
#pragma unroll
                for (int bj = 0; bj < 2; ++bj) E.template apply<4>(acc[ai][bj], pre[bj], (cur.pm * 2 + ai) * 128 + wr * 64, cur.pn * 2 + bj, wc, lane);
            } else {
#pragma unroll
                for (int bj = 0; bj < 2; ++bj) {
                    typename Epi::Pre pre;
                    E.template prefetch<4>(pre, (cur.pm * 2 + ai) * 128 + wr * 64, cur.pn * 2 + bj, wc, lane);
                    E.template apply<4>(acc[ai][bj], pre, (cur.pm * 2 + ai) * 128 + wr * 64, cur.pn * 2 + bj, wc, lane);
                }
            }
        }
        if (!has_next) break;
#pragma unroll
        for (int a = 0; a < 2; ++a)
#pragma unroll
            for (int b = 0; b < 2; ++b)
#pragma unroll
                for (int m = 0; m < 4; ++m)
#pragma unroll
                    for (int n = 0; n < 2; ++n) acc[a][b][m][n] = (f32x4){0.f, 0.f, 0.f, 0.f};
        cur = nxt; cA = nA; cB = nB; ++ui;
    }
    PG8_WAIT_V(0);
    if (wr == 0) PG8_BAR;
    PG8_BAR;
#undef PG8_SA
#undef PG8_SB
#undef PG8_STAGE
#undef PG8_LDA
#undef PG8_LDB
#undef PG8_MMA
#undef PG8_WAIT_V
#undef PG8_WAIT_L
#undef PG8_BAR
#undef PG8_SCHED
}
}

template <class LA, class LB>
__device__ __forceinline__ void mma_tile_dma(f32x4 (&acc)[4][2], const LA& la, const LB& lb, const int K, LAS unsigned char* lds) {
    using pg8::HTB; using pg8::lds_byte; using pg8::stage_rc;
    const int tid = tid_opaque(), lane = tid & 63, wid = __builtin_amdgcn_readfirstlane(tid >> 6), wm = wid >> 2, wn = wid & 3, fr = lane & 15, fq = lane >> 4;
    const int nkt = K >> 6;
    int sR[2], sC[2];
#pragma unroll
    for (int i = 0; i < 2; ++i) stage_rc(tid * 16 + i * 8192, sR[i], sC[i]);
    const unsigned ldsw = (unsigned)wid * 1024u;
    const int aoff = lds_byte(wm * 64 + fr, fq * 8), boff = lds_byte(wn * 32 + fr, fq * 8);
#define TD_STAGE(kt_) do { const int _s = (kt_) & 3; _Pragma("unroll") for (int _i = 0; _i < 2; ++_i) { \
        __builtin_amdgcn_global_load_lds((const unsigned*)la(sR[_i], (kt_) * 64 + sC[_i]), (LAS unsigned*)(lds + _s * 2 * HTB + ldsw + _i * 8192), 16, 0, 0); \
        __builtin_amdgcn_global_load_lds((const unsigned*)lb(sR[_i], (kt_) * 64 + sC[_i]), (LAS unsigned*)(lds + _s * 2 * HTB + HTB + ldsw + _i * 8192), 16, 0, 0); } } while (0)
    TD_STAGE(0);
    if (nkt > 1) TD_STAGE(1);
    if (nkt > 2) TD_STAGE(2);
    for (int kt = 0; kt < nkt; ++kt) {
        const int ahead = nkt - 1 - kt;
        if (ahead >= 2) asm volatile("s_waitcnt vmcnt(8)" ::: "memory");
        else if (ahead == 1) asm volatile("s_waitcnt vmcnt(4)" ::: "memory");
        else asm volatile("s_waitcnt vmcnt(0)" ::: "memory");
        __builtin_amdgcn_s_barrier();
        asm volatile("" ::: "memory");
        if (kt + 3 < nkt) TD_STAGE(kt + 3);
        const LAS unsigned char* Ab = lds + (kt & 3) * 2 * HTB; const LAS unsigned char* Bb = Ab + HTB;
#pragma unroll
        for (int ks = 0; ks < 2; ++ks) {
            bf16x8 af[4], bfr[2];
#pragma unroll
            for (int mt = 0; mt < 4; ++mt) af[mt] = *(const LAS bf16x8*)(Ab + aoff + mt * 2048 + ks * 1024);
#pragma unroll
            for (int nt = 0; nt < 2; ++nt) bfr[nt] = *(const LAS bf16x8*)(Bb + boff + nt * 2048 + ks * 1024);
#pragma unroll
            for (int mt = 0; mt < 4; ++mt)
#pragma unroll
                for (int nt = 0; nt < 2; ++nt) acc[mt][nt] = __builtin_amdgcn_mfma_f32_16x16x32_bf16(bfr[nt], af[mt], acc[mt][nt], 0, 0, 0);
        }
    }
    asm volatile("s_waitcnt lgkmcnt(0)" ::: "memory");
    __builtin_amdgcn_s_barrier();
    asm volatile("" ::: "memory");
#undef TD_STAGE
}

template <int NKT, class IdFn, class LdFn, class EpFn>
__device__ __forceinline__ void tile_stream(const int nloc, const IdFn& idf, const LdFn& ldf, const EpFn& epf, LAS unsigned char* lds) {
    using pg8::HTB; using pg8::lds_byte; using pg8::stage_rc;
    const int tid = tid_opaque(), lane = tid & 63, wid = __builtin_amdgcn_readfirstlane(tid >> 6), wm = wid >> 2, wn = wid & 3, fr = lane & 15, fq = lane >> 4;
    if (nloc <= 0) return;
    const int total = nloc * NKT;
    int sR[2], sC[2];
#pragma unroll
    for (int i = 0; i < 2; ++i) stage_rc(tid * 16 + i * 8192, sR[i], sC[i]);
    const unsigned ldsw = (unsigned)wid * 1024u;
    const int aoff = lds_byte(wm * 64 + fr, fq * 8), boff = lds_byte(wn * 32 + fr, fq * 8);
#define TS_STAGE(j_) do { const int _j = (j_), _t = _j / NKT, _kt = _j - _t * NKT, _s = _j & 3; const int _id = idf(_t); _Pragma("unroll") for (int _i = 0; _i < 2; ++_i) { \
        const bf16_t* _pa; const bf16_t* _pb; ldf(_id, sR[_i], _kt * 64 + sC[_i], _pa, _pb); \
        __builtin_amdgcn_global_load_lds((const unsigned*)_pa, (LAS unsigned*)(lds + _s * 2 * HTB + ldsw + _i * 8192), 16, 0, 0); \
        __builtin_amdgcn_global_load_lds((const unsigned*)_pb, (LAS unsigned*)(lds + _s * 2 * HTB + HTB + ldsw + _i * 8192), 16, 0, 0); } } while (0)
    TS_STAGE(0);
    if (total > 1) TS_STAGE(1);
    if (total > 2) TS_STAGE(2);
    f32x4 acc[4][2]; zero_acc(acc);
    int kt = 0, tl = 0;
#pragma unroll 1
    for (int j = 0; j < total; ++j) {
        const int ahead = total - 1 - j;
        if (ahead >= 2) asm volatile("s_waitcnt vmcnt(8)" ::: "memory");
        else if (ahead == 1) asm volatile("s_waitcnt vmcnt(4)" ::: "memory");
        else asm volatile("s_waitcnt vmcnt(0)" ::: "memory");
        __builtin_amdgcn_s_barrier();
        asm volatile("" ::: "memory");
        if (j + 3 < total) TS_STAGE(j + 3);
        const LAS unsigned char* Ab = lds + (j & 3) * 2 * HTB; const LAS unsigned char* Bb = Ab + HTB;
#pragma unroll
        for (int ks = 0; ks < 2; ++ks) {
            bf16x8 af[4], bfr[2];
#pragma unroll
            for (int mt = 0; mt < 4; ++mt) af[mt] = *(const LAS bf16x8*)(Ab + aoff + mt * 2048 + ks * 1024);
#pragma unroll
            for (int nt = 0; nt < 2; ++nt) bfr[nt] = *(const LAS bf16x8*)(Bb + boff + nt * 2048 + ks * 1024);
#pragma unroll
            for (int mt = 0; mt < 4; ++mt)
#pragma unroll
                for (int nt = 0; nt < 2; ++nt) acc[mt][nt] = __builtin_amdgcn_mfma_f32_16x16x32_bf16(bfr[nt], af[mt], acc[mt][nt], 0, 0, 0);
        }
        if (++kt == NKT) { epf(idf(tl), acc, wm, wn, lane); zero_acc(acc); kt = 0; ++tl; }
    }
    asm volatile("s_waitcnt lgkmcnt(0)" ::: "memory");
    __builtin_amdgcn_s_barrier();
    asm volatile("" ::: "memory");
#undef TS_STAGE
}

__device__ __forceinline__ void phase_modv(const Ctx& p, LAS unsigned char* lds) {
    LAS float* sl = (LAS float*)lds;
    LAS float* part = sl + 3 * 1024;
    const int tid = threadIdx.x;
    for (int i = tid; i < 3 * 1024; i += NT) {
        const int mi = i >> 10, k = i & 1023;
        const float v = mi < 2 ? p.in(I_C)[mi * 1024 + k] : p.in(I_CCTX)[k];
        sl[i] = silu_f(v);
    }
    __syncthreads();
    float* modv = (float*)(p.ws() + OFF_MODV);
    for (int u = blockIdx.x; u < 4 * 96; u += gridDim.x) {
        const int l = u / 96, cb = u % 96, col = cb * 64 + (tid & 63), kp = tid >> 6;
        const float* w = p.in(I_WMOD) + (size_t)l * 1024 * 6144 + col;
        float a0 = 0.f, a1 = 0.f, a2 = 0.f;
#pragma unroll 32
        for (int k = kp * 128; k < kp * 128 + 128; ++k) {
            const float wv = w[(size_t)k * 6144];
            a0 += sl[k] * wv; a1 += sl[1024 + k] * wv; a2 += sl[2048 + k] * wv;
        }
        part[(kp * 3 + 0) * 64 + (tid & 63)] = a0; part[(kp * 3 + 1) * 64 + (tid & 63)] = a1; part[(kp * 3 + 2) * 64 + (tid & 63)] = a2;
        __syncthreads();
        if (tid < 192) {
            const int mi = tid >> 6, c = tid & 63;
            float s = p.in(I_BMOD)[l * 6144 + cb * 64 + c];
#pragma unroll
            for (int q = 0; q < 8; ++q) s += part[(q * 3 + mi) * 64 + c];
            modv[((size_t)l * 3 + mi) * 6144 + cb * 64 + c] = s;
        }
        __syncthreads();
    }
    if (blockIdx.x == gridDim.x - 1) {
        float* rope = (float*)(p.ws() + OFF_ROPE);
        for (int i = tid; i < 320 * 32; i += NT) {
            const int pos = i >> 5, j = i & 31;
            const float fr = powf(10000.f, -(float)j / 32.f);
            const float posf = pos < 256 ? (float)pos : (float)(pos - 256);
            float s, c; sincosf(posf * fr, &s, &c);
            if (pos < 256) { rope[pos * 32 + j] = c; rope[8192 + pos * 32 + j] = s; }
            else { rope[16384 + (pos - 256) * 32 + j] = c; rope[16384 + 2048 + (pos - 256) * 32 + j] = s; }
        }
    }
}

template <class F>
__device__ __forceinline__ void transpose_unit(bf16_t* __restrict__ dst, const float* __restrict__ src, int ldsrc, int K, int n0, int k0, F srccol) {
    const int tid_ = tid_opaque(), n = n0 + (tid_ & 63), kb = tid_ >> 6, sc = srccol(n);
#pragma unroll
    for (int kk = 0; kk < 8; ++kk) {
        const int k = k0 + kb * 64 + kk * 8;
        float v[8];
#pragma unroll
        for (int i = 0; i < 8; ++i) v[i] = src[(size_t)(k + i) * ldsrc + sc];
        uint4 o; o.x = pack_bf16(v[0], v[1]); o.y = pack_bf16(v[2], v[3]); o.z = pack_bf16(v[4], v[5]); o.w = pack_bf16(v[6], v[7]);
        *(uint4*)(dst + (size_t)n * K + k) = o;
    }
}
__device__ __forceinline__ int rope_perm(int n) {
    const int wn = n >> 5, half = (n >> 4) & 1, i = n & 15;
    return (wn >> 1) * 64 + half * 32 + (wn & 1) * 16 + i;
}
__device__ __forceinline__ void convert_unit(bf16_t* __restrict__ dst, const float* __restrict__ src, size_t e0) {
#pragma unroll
    for (int it = 0; it < 8; ++it) {
        const size_t e = e0 + (size_t)(it * NT + tid_opaque()) * 8;
        const float4 a = *(const float4*)(src + e), b = *(const float4*)(src + e + 4);
        uint4 o; o.x = pack_bf16(a.x, a.y); o.y = pack_bf16(a.z, a.w); o.z = pack_bf16(b.x, b.y); o.w = pack_bf16(b.z, b.w);
        *(uint4*)(dst + e) = o;
    }
}
__device__ __forceinline__ void s5_prep_group(const Ctx& p, int l, int g, int q4, LAS unsigned char* lds);
__device__ __forceinline__ void fp8_rows_unit(unsigned char* __restrict__ dst, float* __restrict__ sinv, const float* __restrict__ src, int row0) {
    const int tid = tid_opaque(), lane = tid & 63, wid = tid >> 6;
#pragma unroll
    for (int rr = 0; rr < 4; ++rr) {
        const int row = row0 + wid * 4 + rr;
        const float* sp = src + (size_t)row * D + lane * 16;
        float4 v[4]; float amax = 0.f;
#pragma unroll
        for (int i = 0; i < 4; ++i) { v[i] = *(const float4*)(sp + i * 4); amax = fmaxf(amax, fmaxf(fmaxf(fabsf(v[i].x), fabsf(v[i].y)), fmaxf(fabsf(v[i].z), fabsf(v[i].w)))); }
#pragma unroll
        for (int o = 32; o > 0; o >>= 1) amax = fmaxf(amax, __shfl_xor(amax, o));
        int e = (int)((__float_as_uint(amax) >> 23) & 0xFFu) - 127;
        e = e < -100 ? -100 : (e > 100 ? 100 : e);
        const float sc = __uint_as_float((unsigned)(127 + 7 - e) << 23), inv = __uint_as_float((unsigned)(127 - 7 + e) << 23);
        u32x4 o4;
#pragma unroll
        for (int i = 0; i < 4; ++i) {
            int w = __builtin_amdgcn_cvt_pk_fp8_f32(v[i].x * sc, v[i].y * sc, 0, false);
            w = __builtin_amdgcn_cvt_pk_fp8_f32(v[i].z * sc, v[i].w * sc, w, true);
            o4[i] = (unsigned)w;
        }
        *(u32x4*)(dst + (size_t)row * D + lane * 16) = o4;
        if (lane == 0) sinv[row] = inv;
    }
}
__device__ __forceinline__ void phase_prep(const Ctx& p, int l, int rot, LAS unsigned char* lds) {
    constexpr int U_S5 = 128, U_WIN = 144, U_GLU = 32, U_RU = 16, U_OUT = 32, U_WQ = 32, U_PU = 512, U_PV = 512, U_SK = 4;
    constexpr int B_WIN = U_S5, B_GLU = B_WIN + U_WIN, B_RU = B_GLU + U_GLU, B_OUT = B_RU + U_RU, B_WQ = B_OUT + U_OUT, B_PU = B_WQ + U_WQ,
                  B_PV = B_PU + U_PU, B_SK = B_PV + U_PV, NU = B_SK + U_SK;
    for (int u = (blockIdx.x + rot) % gridDim.x; u < NU; u += gridDim.x) {
        if (u < B_WIN) {
            s5_prep_group(p, l, u >> 2, u & 3, lds);
        } else if (u < B_GLU) {
            const int v = u - B_WIN;
            transpose_unit((bf16_t*)(wsw(p, l) + OFF_WINT), p.in(I_WIN) + (size_t)l * D * INC, INC, D, (v >> 1) * 64, (v & 1) * 512,
                           [](int n) { return (n >= 512 && n < 1536) ? 512 + ((n - 512) >> 7) * 128 + rope_perm((n - 512) & 127) : n; });
        } else if (u < B_RU) {
            const int v = u - B_GLU;
            transpose_unit((bf16_t*)(wsw(p, l) + OFF_WGLUT), p.in(I_WGLU) + (size_t)l * 512 * 2048, 2048, 512, v * 64, 0,
                           [](int n) { const int ntile = n >> 7, q = n & 127; return ((q >> 4) & 1) * 1024 + ntile * 64 + (q >> 5) * 16 + (q & 15); });
        } else if (u < B_OUT) {
            const int v = u - B_RU;
            transpose_unit((bf16_t*)(wsw(p, l) + OFF_WRUT), p.in(I_WRU) + (size_t)l * 512 * 1024, 1024, 512, v * 64, 0, [](int n) { return n; });
        } else if (u < B_WQ) {
            const int v = u - B_OUT;
            transpose_unit((bf16_t*)(wsw(p, l) + OFF_WOUTT), p.in(I_WOUT) + (size_t)l * D * D, D, D, (v >> 1) * 64, (v & 1) * 512, [](int n) { return n; });
        } else if (u < B_PU) {
            const int v = u - B_WQ;
            transpose_unit((bf16_t*)(wsw(p, l) + OFF_WQT), p.in(I_WQ) + (size_t)l * D * D, D, D, (v >> 1) * 64, (v & 1) * 512, [](int n) { return n; });
        } else if (u < B_PV) {
            fp8_rows_unit(wsw(p, l) + OFF_PU, (float*)(wsw(p, l) + OFF_SCU), p.in(I_PU) + (size_t)l * NEXP * D, (u - B_PU) * 32);
        } else if (u < B_SK) {
            fp8_rows_unit(wsw(p, l) + OFF_PV, (float*)(wsw(p, l) + OFF_SCV), p.in(I_PV) + (size_t)l * NEXP * D, (u - B_PV) * 32);
        } else {
            convert_unit((bf16_t*)(wsw(p, l) + OFF_SKEY), p.in(I_SKEY) + (size_t)l * 16 * 128 * 64, (size_t)(u - B_SK) * 32768);
        }
    }
}

__device__ __forceinline__ const float* x_row_ptr(const Ctx& p, int l, int which, int row) {
    if (row < ML) return (l == 0 && which == 0) ? p.in(I_X) + (size_t)row * D : p.out() + (size_t)row * D;
    return (l == 0 && which == 0) ? p.in(I_CTX) + (size_t)(row - ML) * D : (const float*)(p.ws() + OFF_XC) + (size_t)(row - ML) * D;
}
__device__ __forceinline__ void phase_norm(const Ctx& p, int l, int which) {
    const int tid = tid_opaque(), lane = tid & 63, wid = __builtin_amdgcn_readfirstlane(tid >> 6);
    const float* gain = p.in(which == 0 ? I_N1G : I_N2G) + l * D;
    const float* modv = (const float*)(p.ws() + OFF_MODV) + (size_t)l * 3 * 6144;
    bf16_t* H = (bf16_t*)(p.ws() + OFF_H);
    const int nw = gridDim.x * 8, gw = blockIdx.x * 8 + wid;
    const int mrows = (which == 1 && l == DEPTH - 1) ? ML : M;
#pragma unroll 1
    for (int row0 = gw; row0 < mrows; row0 += 2 * nw) {
        const int row1 = row0 + nw; const bool has1 = row1 < mrows;
        const float* xr0 = x_row_ptr(p, l, which, row0); const float* xr1 = x_row_ptr(p, l, which, has1 ? row1 : row0);
        const float* mv0 = modv + (size_t)mod_index(row0) * 6144 + which * 3072; const float* mv1 = modv + (size_t)mod_index(has1 ? row1 : row0) * 6144 + which * 3072;
        float4 v0[4], v1[4], g[4], sh0[4], sc0[4], sh1[4], sc1[4];
#pragma unroll
        for (int i = 0; i < 4; ++i) {
            const int c = i * 256 + lane * 4;
            v0[i] = *(const float4*)(xr0 + c); v1[i] = *(const float4*)(xr1 + c); g[i] = *(const float4*)(gain + c);
            sh0[i] = *(const float4*)(mv0 + c); sc0[i] = *(const float4*)(mv0 + 1024 + c); sh1[i] = *(const float4*)(mv1 + c); sc1[i] = *(const float4*)(mv1 + 1024 + c);
        }
        float ss0 = 0.f, ss1 = 0.f;
#pragma unroll
        for (int i = 0; i < 4; ++i) {
            ss0 += v0[i].x * v0[i].x + v0[i].y * v0[i].y + v0[i].z * v0[i].z + v0[i].w * v0[i].w;
            ss1 += v1[i].x * v1[i].x + v1[i].y * v1[i].y + v1[i].z * v1[i].z + v1[i].w * v1[i].w;
        }
        ss0 = wave_sum(ss0); ss1 = wave_sum(ss1);
        const float r0 = rsqrtf(ss0 * (1.f / 1024.f) + EPS), r1 = rsqrtf(ss1 * (1.f / 1024.f) + EPS);
#pragma unroll
        for (int i = 0; i < 4; ++i) {
            const int c = i * 256 + lane * 4;
            uint2 o; o.x = pack_bf16(v0[i].x * r0 * g[i].x * (1.f + sc0[i].x) + sh0[i].x, v0[i].y * r0 * g[i].y * (1.f + sc0[i].y) + sh0[i].y);
            o.y = pack_bf16(v0[i].z * r0 * g[i].z * (1.f + sc0[i].z) + sh0[i].z, v0[i].w * r0 * g[i].w * (1.f + sc0[i].w) + sh0[i].w);
            *(uint2*)(H + (size_t)row0 * D + c) = o;
        }
        if (has1) {
#pragma unroll
            for (int i = 0; i < 4; ++i) {
                const int c = i * 256 + lane * 4;
                uint2 o; o.x = pack_bf16(v1[i].x * r1 * g[i].x * (1.f + sc1[i].x) + sh1[i].x, v1[i].y * r1 * g[i].y * (1.f + sc1[i].y) + sh1[i].y);
                o.y = pack_bf16(v1[i].z * r1 * g[i].z * (1.f + sc1[i].z) + sh1[i].z, v1[i].w * r1 * g[i].w * (1.f + sc1[i].w) + sh1[i].w);
                *(uint2*)(H + (size_t)row1 * D + c) = o;
            }
        }
    }
}

struct RowInfo { int b, ts, t; bool lat; };
__device__ __forceinline__ RowInfo row_info(int row) {
    RowInfo r;
    if (row < ML) { r.b = row >> 14; r.t = row & 16383; r.ts = r.t; r.lat = true; }
    else { const int rc = row - ML; r.b = rc >> 8; r.t = rc & 255; r.ts = SEQ + r.t; r.lat = false; }
    return r;
}
__device__ __forceinline__ void store_bf16x4(bf16_t* dst, float a, float b, float c, float d) {
    uint2 o; o.x = pack_bf16(a, b); o.y = pack_bf16(c, d); *(uint2*)dst = o;
}
__device__ __forceinline__ unsigned short f2bf(float f) { return (unsigned short)(pack_bf16(f, 0.f) & 0xFFFFu); }
__device__ __forceinline__ int s5_rowbase(int R) {
    const int b = R / 520, cs = R - b * 520;
    return cs < 512 ? b * SEQ + cs * 32 : ML + b * CTX + (cs - 512) * 32;
}

__device__ __forceinline__ int s5_chunkrow(int row) {
    return row < ML ? (row >> 14) * 520 + ((row & 16383) >> 5) : ((row - ML) >> 8) * 520 + 512 + (((row - ML) & 255) >> 5);
}

__device__ __forceinline__ void s5_prep_group(const Ctx& p, int l, int g, int q4, LAS unsigned char* lds) {
    LAS float* powf = (LAS float*)lds;
    LAS float* powb = powf + 4224;
    LAS float* Gf = powb + 4224;
    LAS float* Gb = Gf + 2048;
    LAS float* Cc = Gb + 2048;
    LAS float* Kt = Cc + 2048;
    const int tid = tid_opaque();
    const int lg = l * 32 + g;
    for (int e = tid; e < 2 * 33 * 64; e += NT) {
        const int dir = e / (33 * 64), k = (e / 64) % 33, pp = e & 63;
        const float lre = p.in(dir ? I_LREB : I_LREF)[lg * 64 + pp], lim = p.in(dir ? I_LIMB : I_LIMF)[lg * 64 + pp];
        const float dt = expf(p.in(dir ? I_LDTB : I_LDTF)[lg]);
        const float mag = expf((float)k * lre * dt);
        float sn, cs; sincosf((float)k * lim * dt, &sn, &cs);
        LAS float* pw = dir ? powb : powf;
        pw[(k * 64 + pp) * 2] = mag * cs; pw[(k * 64 + pp) * 2 + 1] = mag * sn;
    }
    for (int e = tid; e < 2 * 64 * 16; e += NT) {
        const int dir = e >> 10, pp = (e >> 4) & 63, j = e & 15;
        const float lre = p.in(dir ? I_LREB : I_LREF)[lg * 64 + pp], lim = p.in(dir ? I_LIMB : I_LIMF)[lg * 64 + pp];
        const float dt = expf(p.in(dir ? I_LDTB : I_LDTF)[lg]);
        const float mag = expf(lre * dt);
        float sn, cs; sincosf(lim * dt, &sn, &cs);
        const float nr = mag * cs - 1.f, ni = mag * sn, den = lre * lre + lim * lim;
        const float br = (nr * lre + ni * lim) / den, bi = (ni * lre - nr * lim) / den;
        const float Br = p.in(I_BRE)[(lg * 64 + pp) * 16 + j], Bi = p.in(I_BIM)[(lg * 64 + pp) * 16 + j];
        LAS float* G = dir ? Gb : Gf;
        G[(pp * 16 + j) * 2] = br * Br - bi * Bi; G[(pp * 16 + j) * 2 + 1] = br * Bi + bi * Br;
    }
    for (int e = tid; e < 16 * 64; e += NT) {
        Cc[e * 2] = p.in(I_CRE)[lg * 1024 + e]; Cc[e * 2 + 1] = p.in(I_CIM)[lg * 1024 + e];
    }
    __syncthreads();
    for (int e0 = tid; e0 < 63 * 64; e0 += NT) {
        const int idx = e0 >> 6, i = 4 * q4 + ((e0 >> 4) & 3), j = e0 & 15, e = (idx * 16 + i) * 16 + j;
        float acc = 0.f;
        if (idx >= 31) {
            const int lag = idx - 31;
            for (int pp = 0; pp < 64; ++pp) {
                const float cr = Cc[(i * 64 + pp) * 2], ci = Cc[(i * 64 + pp) * 2 + 1], ar = powf[(lag * 64 + pp) * 2], ai = powf[(lag * 64 + pp) * 2 + 1];
                const float zr = cr * ar - ci * ai, zi = cr * ai + ci * ar;
                acc += zr * Gf[(pp * 16 + j) * 2] - zi * Gf[(pp * 16 + j) * 2 + 1];
            }
        }
        if (idx <= 31) {
            const int lag = 31 - idx;
            for (int pp = 0; pp < 64; ++pp) {
                const float cr = Cc[(i * 64 + pp) * 2], ci = Cc[(i * 64 + pp) * 2 + 1], ar = powb[(lag * 64 + pp) * 2], ai = powb[(lag * 64 + pp) * 2 + 1];
                const float zr = cr * ar - ci * ai, zi = cr * ai + ci * ar;
                acc += zr * Gb[(pp * 16 + j) * 2] - zi * Gb[(pp * 16 + j) * 2 + 1];
            }
        }
        if (idx == 31 && i == j) acc += p.in(I_SSMD)[l * 512 + g * 16 + i];
        Kt[e] = acc;
    }
    __syncthreads();
    bf16_t* TV = (bf16_t*)(wsw(p, l) + OFF_S5TV) + (size_t)g * 512 * 768;
    for (int piece = tid; piece < 128 * 96; piece += NT) {
        const int nq = piece / 96, k0 = (piece - nq * 96) * 8, t = nq >> 2, i = 4 * q4 + (nq & 3), n = t * 16 + i;
        float v[8];
        if (k0 < 512) {
            const int s_ = k0 >> 4, j0 = k0 & 15;
#pragma unroll
            for (int q = 0; q < 8; ++q) v[q] = Kt[((31 + t - s_) * 16 + i) * 16 + j0 + q];
        } else {
            const int kk = k0 - 512, comp = kk >> 6, p0 = kk & 63, dir = comp >> 1;
            const LAS float* pw = dir ? powb + (32 - t) * 128 : powf + (t + 1) * 128;
#pragma unroll
            for (int q = 0; q < 8; ++q) {
                const int pp = p0 + q;
                const float cr = Cc[(i * 64 + pp) * 2], ci = Cc[(i * 64 + pp) * 2 + 1], ar = pw[pp * 2], ai = pw[pp * 2 + 1];
                v[q] = (comp & 1) ? -(cr * ai + ci * ar) : (cr * ar - ci * ai);
            }
        }
        uint4 o; o.x = pack_bf16(v[0], v[1]); o.y = pack_bf16(v[2], v[3]); o.z = pack_bf16(v[4], v[5]); o.w = pack_bf16(v[6], v[7]);
        *(uint4*)(TV + (size_t)n * 768 + k0) = o;
    }
    bf16_t* W = (bf16_t*)(wsw(p, l) + OFF_S5W) + (size_t)g * 256 * 512;
    for (int piece = tid; piece < 64 * 64; piece += NT) {
        const int n = 64 * q4 + (piece >> 6), k0 = (piece & 63) * 8, comp = n >> 6, pp = n & 63, s_ = k0 >> 4, j0 = k0 & 15, dir = comp >> 1;
        const LAS float* pw = dir ? powb + (s_ * 64 + pp) * 2 : powf + ((31 - s_) * 64 + pp) * 2;
        const LAS float* G = (dir ? Gb : Gf) + (pp * 16 + j0) * 2;
        const float ar = pw[0], ai = pw[1];
        float v[8];
#pragma unroll
        for (int q = 0; q < 8; ++q) { const float gr = G[q * 2], gi = G[q * 2 + 1]; v[q] = (comp & 1) ? (ar * gi + ai * gr) : (ar * gr - ai * gi); }
        uint4 o; o.x = pack_bf16(v[0], v[1]); o.y = pack_bf16(v[2], v[3]); o.z = pack_bf16(v[4], v[5]); o.w = pack_bf16(v[6], v[7]);
        *(uint4*)(W + (size_t)n * 512 + k0) = o;
    }
    if (tid < 128 && q4 == 0) {
        const int dir = tid >> 6, pp = tid & 63;
        float* AT = (float*)(wsw(p, l) + OFF_S5AT) + ((g * 2 + dir) * 64 + pp) * 2;
        const LAS float* pw = (dir ? powb : powf) + (32 * 64 + pp) * 2;
        AT[0] = pw[0]; AT[1] = pw[1];
    }
    __syncthreads();
}

template <bool SW, class Epi>
__device__ __forceinline__ void thin_ctx_gemm(const bf16_t* A, const bf16_t* Bt, const int K, const int nt_lo, const int nt_hi, const Epi& E, LAS unsigned char* lds) {
    static_assert(SW, "swapped accumulator layout only");
    const int tid = tid_opaque(), lane = tid & 63, wid = __builtin_amdgcn_readfirstlane(tid >> 6), wm = wid >> 2, wn = wid & 3;
    const int ntile = 4 * (nt_hi - nt_lo);
#pragma unroll 1
    for (int t = blockIdx.x; t < ntile; t += gridDim.x) {
        const int mt = t & 3, nt = nt_lo + (t >> 2);
        const bf16_t* Ab = A + (size_t)(ML + mt * 128) * K; const bf16_t* Bb = Bt + (size_t)nt * 128 * K;
        f32x4 acc[4][2]; zero_acc(acc);
        mma_tile_dma(acc, [=](int r, int k) { return Ab + (size_t)r * K + k; }, [=](int r, int k) { return Bb + (size_t)r * K + k; }, K, lds);
        typename Epi::Pre pre;
        E.template prefetch<4>(pre, ML + mt * 128 + wm * 64, nt, wn, lane);
        E.template apply<4>(acc, pre, ML + mt * 128 + wm * 64, nt, wn, lane);
    }
}

struct EpiG1 {
    const Ctx& p; int l;
    template <int NA>
    __device__ __forceinline__ void operator()(const f32x4 (&acc)[NA][2], int rowbase, int nt, int wn, int lane_) const {
        int lane = lane_; asm volatile("" : "+v"(lane));
        const float* rope = (const float*)(p.ws() + OFF_ROPE);
        const int fq = lane >> 4;
        if (nt < 8 || nt >= 16) {
            bf16_t* dst; int ld, c0; bool isq = false;
            if (nt < 4) { dst = (bf16_t*)(p.ws() + OFF_U); ld = 512; c0 = nt * 128; }
            else if (nt < 8) { dst = (bf16_t*)(p.ws() + OFF_Q); ld = 512; c0 = (nt - 4) * 128; isq = true; }
            else if (nt < 20) { dst = (bf16_t*)(p.ws() + OFF_G); ld = 512; c0 = (nt - 16) * 128; }
            else if (nt < 28) { dst = (bf16_t*)(p.ws() + OFF_GS); ld = 1024; c0 = (nt - 20) * 128; }
            else { dst = (bf16_t*)(p.ws() + OFF_GR); ld = 1024; c0 = (nt - 28) * 128; }
            f32x4 rc[NA], rs[NA];
            if (isq) {
#pragma unroll
                for (int a = 0; a < NA; ++a) {
                    const int row = rowbase + a * 16 + (lane & 15);
                    const int t = row & 16383, sec = wn >> 1, pos = (row < ML) ? (sec ? (t & 63) : (t >> 6)) : 0;
                    const float* cs = rope + (sec ? 16384 : 0) + pos * 32 + (wn & 1) * 16 + 4 * fq;
                    rc[a] = *(const f32x4*)cs; rs[a] = *(const f32x4*)(cs + (sec ? 2048 : 8192));
                }
            }
#pragma unroll
            for (int a = 0; a < NA; ++a) {
                const int row = rowbase + a * 16 + (lane & 15);
                f32x4 v0 = acc[a][0], v1 = acc[a][1];
                if (isq && row < ML) {
#pragma unroll
                    for (int r = 0; r < 4; ++r) { const float c = rc[a][r], s_ = rs[a][r], t1 = v0[r], t2 = v1[r]; v0[r] = t1 * c - t2 * s_; v1[r] = t1 * s_ + t2 * c; }
                }
                {
                    bf16_t* rp = nt < 4 ? (bf16_t*)(p.ws() + OFF_AS5) + ((size_t)(nt * 8 + wn * 2) * 1040 + s5_chunkrow(row)) * 768 + (row & 31) * 16 + 4 * fq
                                        : dst + ((size_t)((c0 >> 4) + wn * 2) * M + row) * 16 + 4 * fq;
                    const size_t gstep = nt < 4 ? (size_t)1040 * 768 : (size_t)M * 16;
                    store_bf16x4(rp, v0[0], v0[1], v0[2], v0[3]);
                    store_bf16x4(rp + gstep, v1[0], v1[1], v1[2], v1[3]);
                }
            }
        } else if (nt < 12) {
            const int h = nt - 8;
            const float lgf = -expf(p.in(I_RDF)[l * 4 + h]), lgb = -expf(p.in(I_RDB)[l * 4 + h]);
            bf16_t* Kd = (bf16_t*)(p.ws() + OFF_K); bf16_t* KTF = (bf16_t*)(p.ws() + OFF_KTF); bf16_t* KTB = (bf16_t*)(p.ws() + OFF_KTB);
            const int sec = wn >> 1;
            f32x4 rc[NA], rs[NA];
#pragma unroll
            for (int a = 0; a < NA; ++a) {
                const RowInfo ri = row_info(rowbase + a * 16 + (lane & 15));
                const int pos = ri.lat ? (sec ? (ri.t & 63) : (ri.t >> 6)) : 0;
                const float* cs = rope + (sec ? 16384 : 0) + pos * 32 + (wn & 1) * 16 + 4 * fq;
                rc[a] = *(const f32x4*)cs; rs[a] = *(const f32x4*)(cs + (sec ? 2048 : 8192));
            }
#pragma unroll
            for (int a = 0; a < NA; ++a) {
                const int row = rowbase + a * 16 + (lane & 15);
                const RowInfo ri = row_info(row);
                f32x4 v0 = acc[a][0], v1 = acc[a][1];
                if (ri.lat) {
#pragma unroll
                    for (int r = 0; r < 4; ++r) { const float c = rc[a][r], s_ = rs[a][r], t1 = v0[r], t2 = v1[r]; v0[r] = t1 * c - t2 * s_; v1[r] = t1 * s_ + t2 * c; }
                }
                v0 *= 0.08838834764831845f; v1 *= 0.08838834764831845f;
                bf16_t* rp = Kd + ((size_t)(h * 8 + wn * 2) * M + row) * 16 + 4 * fq;
                store_bf16x4(rp, v0[0], v0[1], v0[2], v0[3]);
                store_bf16x4(rp + (size_t)M * 16, v1[0], v1[1], v1[2], v1[3]);
                const int c_ = ri.t & 127;
                const float ff = __expf(lgf * (float)(127 - c_)), fb = __expf(lgb * (float)c_);
                const size_t tb = ((size_t)(ri.b * 4 + h) * 128 + wn * 32 + 4 * fq) * TS + ri.ts;
#pragma unroll
                for (int r = 0; r < 4; ++r) {
                    KTF[tb + (size_t)r * TS] = f2bf(v0[r] * ff); KTF[tb + (size_t)(r + 16) * TS] = f2bf(v1[r] * ff);
                    KTB[tb + (size_t)r * TS] = f2bf(v0[r] * fb); KTB[tb + (size_t)(r + 16) * TS] = f2bf(v1[r] * fb);
                }
            }
        } else {
            const int h = nt - 12;
            bf16_t* VT = (bf16_t*)(p.ws() + OFF_VT);
#pragma unroll
            for (int a = 0; a < NA; ++a) {
                const int row = rowbase + a * 16 + (lane & 15);
                const RowInfo ri = row_info(row);
                const size_t tb = ((size_t)(ri.b * 4 + h) * 128 + wn * 32 + 4 * fq) * TS + ri.ts;
#pragma unroll
                for (int r = 0; r < 4; ++r) { VT[tb + (size_t)r * TS] = f2bf(acc[a][0][r]); VT[tb + (size_t)(r + 16) * TS] = f2bf(acc[a][1][r]); }
            }
        }
    }
    struct Pre {};
    static constexpr bool PAIR = false;
    template <int NA> __device__ __forceinline__ void prefetch(Pre&, int, int, int, int) const {}
    template <int NA> __device__ __forceinline__ void apply(const f32x4 (&acc)[NA][2], const Pre&, int rowbase, int nt, int wn, int lane) const { this->template operator()<NA>(acc, rowbase, nt, wn, lane); }
};
__device__ __forceinline__ void phase_g1(const Ctx& p, int l, LAS unsigned char* lds) {
    const bf16_t* A = (const bf16_t*)(p.ws() + OFF_H); const bf16_t* Bt = (const bf16_t*)(wsw(p, l) + OFF_WINT);
    pg8::Gemm g{A, Bt, ML, INC, D};
    pg8::StaticOrder S; S.init(ML, INC, (int)gridDim.x, (int)blockIdx.x);
    pg8::gemm_phase(lds, g, S, EpiG1{p, l});
    thin_ctx_gemm<true>(A, Bt, D, 0, 36, EpiG1{p, l}, lds);
}

__device__ __forceinline__ void phase_x1(const Ctx& p, int l, LAS unsigned char* lds) {
    const bf16_t* AS5 = (const bf16_t*)(p.ws() + OFF_AS5);
    constexpr int N_S5 = 32 * 9 * 2, N_RET = NB * 4 * 2 * 130;
    const int xcl = blockIdx.x & 7, xrk = blockIdx.x >> 3, xnp = gridDim.x >> 3;
    {
        const bf16_t* W = (const bf16_t*)(wsw(p, l) + OFF_S5W);
        float* SB = (float*)(p.ws() + OFF_SBUF);
        const int nloc = (4 * 16 - xrk + xnp - 1) / xnp;
        auto idf = [=](int i) { const int tq = xrk + i * xnp; return (xcl + 8 * (tq / 16)) * 18 + tq % 16; };
        auto ldf = [=](int id, int r, int k, const bf16_t*& pa, const bf16_t*& pb) {
            const int g = id / 18, r_ = id - g * 18, mt = r_ >> 1, nt = r_ & 1;
            int R = mt * 128 + r; R = R < 1040 ? R : 1039;
            pa = AS5 + ((size_t)g * 1040 + R) * 768 + k;
            pb = W + ((size_t)g * 256 + nt * 128 + r) * 512 + k;
        };
        auto epf = [=](int id, const f32x4 (&acc)[4][2], int wm, int wn, int lane) {
            const int g = id / 18, r_ = id - g * 18, mt = r_ >> 1, nt = r_ & 1;
#pragma unroll
            for (int a = 0; a < 4; ++a) {
                const int R = mt * 128 + wm * 64 + a * 16 + (lane & 15);
                if (R < 1040) {
#pragma unroll
                    for (int b2 = 0; b2 < 2; ++b2) *(f32x4*)(SB + ((size_t)g * 1040 + R) * 256 + nt * 128 + wn * 32 + b2 * 16 + 4 * (lane >> 4)) = acc[a][b2];
                }
            }
        };
        tile_stream<8>(nloc, idf, ldf, epf, lds);
        if (xrk < 8) {
            const int tid = tid_opaque(), lane = tid & 63, wid = __builtin_amdgcn_readfirstlane(tid >> 6), fr = lane & 15, fq = lane >> 4;
            const int g = xcl + 8 * (xrk >> 1), nt = xrk & 1;
            const bf16_t* Ap = AS5 + ((size_t)g * 1040 + 1024 + fr) * 768 + fq * 8;
            const bf16_t* Bp = W + ((size_t)g * 256 + nt * 128 + wid * 16 + fr) * 512 + fq * 8;
            f32x4 acc0 = {0.f, 0.f, 0.f, 0.f}, acc1 = {0.f, 0.f, 0.f, 0.f};
#pragma unroll
            for (int h = 0; h < 2; ++h) {
                bf16x8 av[8], bv[8];
#pragma unroll
                for (int j = 0; j < 8; ++j) { av[j] = *(const bf16x8*)(Ap + (h * 8 + j) * 32); bv[j] = *(const bf16x8*)(Bp + (h * 8 + j) * 32); }
#pragma unroll
                for (int j = 0; j < 8; j += 2) {
                    acc0 = __builtin_amdgcn_mfma_f32_16x16x32_bf16(bv[j], av[j], acc0, 0, 0, 0);
                    acc1 = __builtin_amdgcn_mfma_f32_16x16x32_bf16(bv[j + 1], av[j + 1], acc1, 0, 0, 0);
                }
            }
            *(f32x4*)(SB + ((size_t)g * 1040 + 1024 + fr) * 256 + nt * 128 + wid * 16 + 4 * fq) = acc0 + acc1;
        }
    }
    {
        const bf16_t* VT = (const bf16_t*)(p.ws() + OFF_VT); const bf16_t* KTF = (const bf16_t*)(p.ws() + OFF_KTF); const bf16_t* KTB = (const bf16_t*)(p.ws() + OFF_KTB);
        bf16_t* KVo = (bf16_t*)(p.ws() + OFF_KV);
        const int first = (blockIdx.x + 64) % gridDim.x;
        const int nloc = (N_RET - first + (int)gridDim.x - 1) / (int)gridDim.x;
        auto idf = [=](int i) { return first + i * (int)gridDim.x; };
        auto ldf = [=](int q, int r, int k, const bf16_t*& pa, const bf16_t*& pb) {
            const int n = q % 130, dir = (q / 130) & 1, bh = q / 260;
            pa = VT + ((size_t)bh * 128 + r) * TS + n * 128 + k;
            pb = (dir ? KTB : KTF) + ((size_t)bh * 128 + r) * TS + n * 128 + k;
        };
        auto epf = [=](int q, const f32x4 (&acc)[4][2], int wm, int wn, int lane) {
            const int n = q % 130, dir = (q / 130) & 1, bh = q / 260;
            bf16_t* KV = KVo + ((size_t)(bh * 2 + dir) * 130 + n) * 16384;
#pragma unroll
            for (int a = 0; a < 4; ++a)
#pragma unroll
                for (int b2 = 0; b2 < 2; ++b2)
                    store_bf16x4(KV + (wm * 64 + a * 16 + (lane & 15)) * 128 + wn * 32 + b2 * 16 + 4 * (lane >> 4), acc[a][b2][0], acc[a][b2][1], acc[a][b2][2], acc[a][b2][3]);
        };
        tile_stream<2>(nloc, idf, ldf, epf, lds);
    }
}

__device__ __forceinline__ void phase_x2(const Ctx& p, int l, LAS unsigned char* lds) {
    const int tid = tid_opaque();
    {
        const int gid = blockIdx.x * NT + tid;
        if (gid < 16 * 8192) {
            const int seq = gid >> 13, off = (gid & 8191) * 2, dir = seq & 1, h = (seq >> 1) & 3;
            const float lg = -expf(p.in(dir ? I_RDB : I_RDF)[l * 4 + h]);
            const float dec = expf(128.f * lg);
            const bf16_t* KV = (const bf16_t*)(p.ws() + OFF_KV) + (size_t)seq * 130 * 16384 + off;
            bf16_t* SB = (bf16_t*)(p.ws() + OFF_SBEF) + (size_t)seq * 130 * 16384 + off;
            float s0 = 0.f, s1 = 0.f;
#pragma unroll 1
            for (int v0 = 0; v0 < 130; v0 += 26) {
                unsigned kv[26];
#pragma unroll
                for (int j = 0; j < 26; ++j) { const int v = v0 + j, n = dir ? 129 - v : (v < 2 ? 128 + v : v - 2); kv[j] = *(const unsigned*)(KV + (size_t)n * 16384); }
#pragma unroll
                for (int j = 0; j < 26; ++j) {
                    const int v = v0 + j, n = dir ? 129 - v : (v < 2 ? 128 + v : v - 2);
                    *(unsigned*)(SB + (size_t)n * 16384) = pack_bf16(s0, s1);
                    s0 = dec * s0 + __uint_as_float(kv[j] << 16); s1 = dec * s1 + __uint_as_float(kv[j] & 0xFFFF0000u);
                }
            }
        }
    }
    if (blockIdx.x < 128) {
        const int u = blockIdx.x, b = u >> 6, g = (u >> 1) & 31, dir = u & 1;
        LAS float* tot = (LAS float*)lds;
        const float* SBUF = (const float*)(p.ws() + OFF_SBUF) + ((size_t)g * 1040 + b * 520) * 256 + dir * 128;
        bf16_t* HIN = (bf16_t*)(p.ws() + OFF_AS5) + ((size_t)g * 1040 + b * 520) * 768 + 512 + dir * 128;
        const int seg = tid >> 6, pp = tid & 63, v0 = seg * 65;
        const float* AT = (const float*)(wsw(p, l) + OFF_S5AT) + ((g * 2 + dir) * 64 + pp) * 2;
        const float ar = AT[0], ai = AT[1];
        float hr = 0.f, hi = 0.f;
#pragma unroll 13
        for (int i = 0; i < 65; ++i) {
            const int v = v0 + i, cs = dir ? 519 - v : (v < 8 ? 512 + v : v - 8);
            const float sr = SBUF[(size_t)cs * 256 + pp], si = SBUF[(size_t)cs * 256 + 64 + pp];
            const float nr = ar * hr - ai * hi + sr, ni = ar * hi + ai * hr + si;
            hr = nr; hi = ni;
        }
        tot[(seg * 64 + pp) * 2] = hr; tot[(seg * 64 + pp) * 2 + 1] = hi;
        float br = 1.f, bi = 0.f;
        for (int i = 0; i < 65; ++i) { const float nr = br * ar - bi * ai, ni = br * ai + bi * ar; br = nr; bi = ni; }
        __syncthreads();
        hr = 0.f; hi = 0.f;
        for (int s2 = 0; s2 < seg; ++s2) {
            const float tr = tot[(s2 * 64 + pp) * 2], ti = tot[(s2 * 64 + pp) * 2 + 1];
            const float nr = br * hr - bi * hi + tr, ni = br * hi + bi * hr + ti;
            hr = nr; hi = ni;
        }
#pragma unroll 1
        for (int i0 = 0; i0 < 65; i0 += 13) {
            float sr[13], si[13];
#pragma unroll
            for (int j = 0; j < 13; ++j) { const int v = v0 + i0 + j, cs = dir ? 519 - v : (v < 8 ? 512 + v : v - 8); sr[j] = SBUF[(size_t)cs * 256 + pp]; si[j] = SBUF[(size_t)cs * 256 + 64 + pp]; }
#pragma unroll
            for (int j = 0; j < 13; ++j) {
                const int v = v0 + i0 + j, cs = dir ? 519 - v : (v < 8 ? 512 + v : v - 8);
                HIN[(size_t)cs * 768 + pp] = f2bf(hr); HIN[(size_t)cs * 768 + 64 + pp] = f2bf(hi);
                const float nr = ar * hr - ai * hi + sr[j], ni = ar * hi + ai * hr + si[j];
                hr = nr; hi = ni;
            }
        }
        __syncthreads();
    }
}

struct S5cOrder {
    int c;
    __device__ __forceinline__ bool next(int i, pg8::Unit& u) const {
        if (i > 0) return false;
        const int xcl = c & 7, xrk = c >> 3, g = xcl + 8 * (xrk >> 3);
        u.pm = g * 4 + ((xrk & 7) >> 1); u.pn = xrk & 1; return true;
    }
    __device__ __forceinline__ const char* abase(const pg8::Gemm& g, const pg8::Unit& u) const { return (const char*)g.A + ((size_t)(u.pm >> 2) * 1040 + (u.pm & 3) * 256) * (768 * 2); }
    __device__ __forceinline__ const char* bbase(const pg8::Gemm& g, const pg8::Unit& u) const { return (const char*)g.Bt + ((size_t)(u.pm >> 2) * 512 + u.pn * 256) * (768 * 2); }
};
struct EpiS5C {
    const Ctx& p;
    struct Pre {};
    static constexpr bool PAIR = false;
    template <int NA> __device__ __forceinline__ void prefetch(Pre&, int, int, int, int) const {}
    template <int NA>
    __device__ __forceinline__ void apply(const f32x4 (&acc)[NA][2], const Pre&, int rowbase, int nt, int wn, int lane_) const {
        int lane = lane_; asm volatile("" : "+v"(lane));
        bf16_t* YS = (bf16_t*)(p.ws() + OFF_YS);
        const int g = rowbase >> 10;
#pragma unroll
        for (int a = 0; a < NA; ++a) {
            const int rb = s5_rowbase((rowbase & 1023) + a * 16 + (lane & 15));
#pragma unroll
            for (int b2 = 0; b2 < 2; ++b2) {
                const int n = nt * 128 + wn * 32 + b2 * 16 + 4 * (lane >> 4), t = n >> 4, i = n & 15;
                store_bf16x4(YS + (size_t)(rb + t) * 512 + g * 16 + i, gelu_tanh_f(acc[a][b2][0]), gelu_tanh_f(acc[a][b2][1]), gelu_tanh_f(acc[a][b2][2]), gelu_tanh_f(acc[a][b2][3]));
            }
        }
    }
};
__device__ __forceinline__ void phase_x3(const Ctx& p, int l, LAS unsigned char* lds) {
    const int tid = tid_opaque(), lane = tid & 63, wid = __builtin_amdgcn_readfirstlane(tid >> 6), wm = wid >> 2, wn = wid & 3;
    constexpr int N_RET = NB * 4 * 130;
    const int xcl = blockIdx.x & 7, xrk = blockIdx.x >> 3;
    {
        pg8::Gemm g{(const bf16_t*)(p.ws() + OFF_AS5), (const bf16_t*)(wsw(p, l) + OFF_S5TV), 32 * 1024, 512, 768};
        S5cOrder S; S.c = (int)blockIdx.x;
        pg8::gemm_phase(lds, g, S, EpiS5C{p});
    }
    if (xrk < 16) {
        const int g = xcl + 8 * (xrk >> 2), nt = xrk & 3, fr = lane & 15, fq = lane >> 4;
        const bf16_t* Ap = (const bf16_t*)(p.ws() + OFF_AS5) + ((size_t)g * 1040 + 1024 + fr) * 768 + fq * 8;
        const bf16_t* Bp = (const bf16_t*)(wsw(p, l) + OFF_S5TV) + ((size_t)g * 512 + nt * 128 + wid * 16 + fr) * 768 + fq * 8;
        f32x4 acc0 = {0.f, 0.f, 0.f, 0.f}, acc1 = {0.f, 0.f, 0.f, 0.f};
#pragma unroll
        for (int h = 0; h < 2; ++h) {
            bf16x8 av[12], bv[12];
#pragma unroll
            for (int j = 0; j < 12; ++j) { av[j] = *(const bf16x8*)(Ap + (h * 12 + j) * 32); bv[j] = *(const bf16x8*)(Bp + (h * 12 + j) * 32); }
#pragma unroll
            for (int j = 0; j < 12; j += 2) {
                acc0 = __builtin_amdgcn_mfma_f32_16x16x32_bf16(bv[j], av[j], acc0, 0, 0, 0);
                acc1 = __builtin_amdgcn_mfma_f32_16x16x32_bf16(bv[j + 1], av[j + 1], acc1, 0, 0, 0);
            }
        }
        const f32x4 acc = acc0 + acc1;
        bf16_t* YS = (bf16_t*)(p.ws() + OFF_YS);
        const int rb = s5_rowbase(1024 + fr), t = nt * 8 + wid;
        store_bf16x4(YS + (size_t)(rb + t) * 512 + g * 16 + 4 * fq, gelu_tanh_f(acc[0]), gelu_tanh_f(acc[1]), gelu_tanh_f(acc[2]), gelu_tanh_f(acc[3]));
    }
    {
        using pg8::HTB; using pg8::lds_byte; using pg8::stage_rc;
        constexpr int QO = 0, S0 = 2 * HTB, S1 = 4 * HTB, PO = 6 * HTB, RED = 8 * HTB;
        const int fr = lane & 15, fq = lane >> 4;
        int sR[2], sC[2];
#pragma unroll
        for (int i = 0; i < 2; ++i) stage_rc(tid * 16 + i * 8192, sR[i], sC[i]);
        const unsigned ldsw = (unsigned)wid * 1024u;
        const int aoff = lds_byte(wm * 64 + fr, fq * 8), boff = lds_byte(wn * 32 + fr, fq * 8);
#define RC_STAGE(off, base, ld) do { _Pragma("unroll") for (int _kh = 0; _kh < 2; ++_kh) { _Pragma("unroll") for (int _i = 0; _i < 2; ++_i) \
            __builtin_amdgcn_global_load_lds((const unsigned*)((base) + (size_t)sR[_i] * (ld) + sC[_i] + 64 * _kh), (LAS unsigned*)(lds + (off) + _kh * HTB + ldsw + _i * 8192), 16, 0, 0); } } while (0)
#define RC_STAGE_G(off, base) do { _Pragma("unroll") for (int _kh = 0; _kh < 2; ++_kh) { _Pragma("unroll") for (int _i = 0; _i < 2; ++_i) \
            __builtin_amdgcn_global_load_lds((const unsigned*)((base) + ((size_t)((sC[_i] + 64 * _kh) >> 4) * M + sR[_i]) * 16 + (sC[_i] & 15)), (LAS unsigned*)(lds + (off) + _kh * HTB + ldsw + _i * 8192), 16, 0, 0); } } while (0)
#define RC_MMA(aimg, bimg) do { _Pragma("unroll") for (int _k = 0; _k < 4; ++_k) { bf16x8 _af[4], _bf[2]; \
            _Pragma("unroll") for (int m = 0; m < 4; ++m) _af[m] = *(const LAS bf16x8*)(lds + (aimg) + (_k >> 1) * HTB + aoff + m * 2048 + (_k & 1) * 1024); \
            _Pragma("unroll") for (int n2 = 0; n2 < 2; ++n2) _bf[n2] = *(const LAS bf16x8*)(lds + (bimg) + (_k >> 1) * HTB + boff + n2 * 2048 + (_k & 1) * 1024); \
            _Pragma("unroll") for (int m = 0; m < 4; ++m) _Pragma("unroll") for (int n2 = 0; n2 < 2; ++n2) \
                acc[m][n2] = __builtin_amdgcn_mfma_f32_16x16x32_bf16(_bf[n2], _af[m], acc[m][n2], 0, 0, 0); } } while (0)
#define RC_WAIT(n) asm volatile("s_waitcnt vmcnt(" #n ")" ::: "memory")
#define RC_BAR() do { asm volatile("s_waitcnt lgkmcnt(0)" ::: "memory"); __builtin_amdgcn_s_barrier(); asm volatile("" ::: "memory"); } while (0)
#pragma unroll 1
        for (int id = (blockIdx.x + gridDim.x / 2) % gridDim.x; id < N_RET; id += gridDim.x) {
            const int n = id % 130, bh = id / 130, h = bh & 3, b = bh >> 2;
            if (l == DEPTH - 1 && n >= 128) continue;
            const int rowbase = n < 128 ? b * SEQ + n * 128 : ML + b * CTX + (n - 128) * 128;
            const float lgf = -expf(p.in(I_RDF)[l * 4 + h]), lgb = -expf(p.in(I_RDB)[l * 4 + h]);
            const bf16_t* Qb = (const bf16_t*)(p.ws() + OFF_Q) + ((size_t)(h * 8) * M + rowbase) * 16;
            const bf16_t* Kb = (const bf16_t*)(p.ws() + OFF_K) + ((size_t)(h * 8) * M + rowbase) * 16;
            const bf16_t* Sf = (const bf16_t*)(p.ws() + OFF_SBEF) + ((size_t)(bh * 2 + 0) * 130 + n) * 16384;
            const bf16_t* Rb = (const bf16_t*)(p.ws() + OFF_SBEF) + ((size_t)(bh * 2 + 1) * 130 + n) * 16384;
            const bf16_t* Vb = (const bf16_t*)(p.ws() + OFF_VT) + (size_t)bh * 128 * TS + n * 128;
            const bf16_t* G = (const bf16_t*)(p.ws() + OFF_G) + ((size_t)(h * 8) * M + rowbase) * 16;
            uint2 gv[4][2];
#pragma unroll
            for (int a = 0; a < 4; ++a)
#pragma unroll
                for (int b2 = 0; b2 < 2; ++b2) gv[a][b2] = *(const uint2*)(G + ((size_t)(wn * 2 + b2) * M + wm * 64 + a * 16 + fr) * 16 + 4 * fq);
            RC_STAGE_G(QO, Qb); RC_STAGE_G(S0, Kb); RC_STAGE(S1, Rb, 128);
            f32x4 acc[4][2]; zero_acc(acc);
            RC_WAIT(4); RC_BAR();
            RC_MMA(QO, S0);
#pragma unroll
            for (int a = 0; a < 4; ++a) {
                const int c = wm * 64 + a * 16 + fr;
#pragma unroll
                for (int b2 = 0; b2 < 2; ++b2) {
                    const int m0 = wn * 32 + b2 * 16 + 4 * fq;
                    float pv[4];
#pragma unroll
                    for (int r = 0; r < 4; ++r) { const int m = m0 + r; pv[r] = acc[a][b2][r] * (c >= m ? __expf(lgf * (float)(c - m)) : __expf(lgb * (float)(m - c))); }
                    u32x2 o; o[0] = pack_bf16(pv[0], pv[1]); o[1] = pack_bf16(pv[2], pv[3]);
                    *(LAS u32x2*)(lds + PO + (m0 >> 6) * HTB + lds_byte(c, m0 & 63)) = o;
                }
            }
            RC_BAR();
            RC_STAGE(S0, Sf, 128);
            zero_acc(acc);
            RC_WAIT(4); RC_BAR();
            RC_MMA(QO, S1);
#pragma unroll
            for (int a = 0; a < 4; ++a) {
                const int c = wm * 64 + a * 16 + fr;
                const float rr = __expf(lgb * (float)(128 - c) - lgf * (float)(c + 1));
#pragma unroll
                for (int b2 = 0; b2 < 2; ++b2)
#pragma unroll
                    for (int r = 0; r < 4; ++r) acc[a][b2][r] *= rr;
            }
            RC_BAR();
            RC_STAGE(S1, Vb, TS);
            RC_WAIT(4); RC_BAR();
            RC_MMA(QO, S0);
#pragma unroll
            for (int a = 0; a < 4; ++a) {
                const int c = wm * 64 + a * 16 + fr;
                const float ff = __expf(lgf * (float)(c + 1));
#pragma unroll
                for (int b2 = 0; b2 < 2; ++b2)
#pragma unroll
                    for (int r = 0; r < 4; ++r) acc[a][b2][r] *= ff;
            }
            RC_WAIT(0); RC_BAR();
            RC_MMA(PO, S1);
            LAS float* red = (LAS float*)(lds + RED);
#pragma unroll
            for (int a = 0; a < 4; ++a) {
                float ss = 0.f;
#pragma unroll
                for (int b2 = 0; b2 < 2; ++b2)
#pragma unroll
                    for (int r = 0; r < 4; ++r) ss += acc[a][b2][r] * acc[a][b2][r];
                ss += __shfl_xor(ss, 16); ss += __shfl_xor(ss, 32);
                if (lane < 16) red[wn * 128 + wm * 64 + a * 16 + lane] = ss;
            }
            RC_BAR();
            bf16_t* YR = (bf16_t*)(p.ws() + OFF_YR);
#pragma unroll
            for (int a = 0; a < 4; ++a) {
                const int c = wm * 64 + a * 16 + fr;
                const float tot = red[c] + red[128 + c] + red[256 + c] + red[384 + c];
                const float rstd = rsqrtf(tot * (1.f / 128.f) + EPS);
#pragma unroll
                for (int b2 = 0; b2 < 2; ++b2) {
                    const int e = wn * 32 + b2 * 16 + 4 * fq;
                    const uint2 g_ = gv[a][b2];
                    const float g0 = __uint_as_float(g_.x << 16), g1 = __uint_as_float(g_.x & 0xFFFF0000u), g2 = __uint_as_float(g_.y << 16), g3 = __uint_as_float(g_.y & 0xFFFF0000u);
                    store_bf16x4(YR + (size_t)(rowbase + c) * 512 + h * 128 + e, acc[a][b2][0] * rstd * silu_f(g0), acc[a][b2][1] * rstd * silu_f(g1),
                                 acc[a][b2][2] * rstd * silu_f(g2), acc[a][b2][3] * rstd * silu_f(g3));
                }
            }
            RC_BAR();
        }
#undef RC_STAGE
#undef RC_STAGE_G
#undef RC_MMA
#undef RC_WAIT
#undef RC_BAR
    }
}

struct EpiG2 {
    const Ctx& p;
    struct Pre { uint2 gs[4]; };
    static constexpr bool PAIR = true;
    template <int NA>
    __device__ __forceinline__ void prefetch(Pre& q, int rowbase, int nt, int wn, int lane) const {
        const bf16_t* GS = (const bf16_t*)(p.ws() + OFF_GS);
#pragma unroll
        for (int a = 0; a < NA; ++a) q.gs[a] = *(const uint2*)(GS + ((size_t)(nt * 4 + wn) * M + rowbase + a * 16 + (lane & 15)) * 16 + 4 * (lane >> 4));
    }
    template <int NA>
    __device__ __forceinline__ void apply(const f32x4 (&acc)[NA][2], const Pre& q, int rowbase, int nt, int wn, int lane) const {
        bf16_t* MP = (bf16_t*)(p.ws() + OFF_H);
#pragma unroll
        for (int a = 0; a < NA; ++a) {
            const int row = rowbase + a * 16 + (lane & 15), j = nt * 64 + wn * 16 + 4 * (lane >> 4);
            const uint2 gv = q.gs[a];
            const float s0 = sigmoid_f(__uint_as_float(gv.x << 16)), s1 = sigmoid_f(__uint_as_float(gv.x & 0xFFFF0000u));
            const float s2 = sigmoid_f(__uint_as_float(gv.y << 16)), s3 = sigmoid_f(__uint_as_float(gv.y & 0xFFFF0000u));
            store_bf16x4(MP + (size_t)row * D + j, acc[a][0][0] * sigmoid_f(acc[a][1][0]) * s0, acc[a][0][1] * sigmoid_f(acc[a][1][1]) * s1,
                         acc[a][0][2] * sigmoid_f(acc[a][1][2]) * s2, acc[a][0][3] * sigmoid_f(acc[a][1][3]) * s3);
        }
    }
};
struct EpiG3 {
    const Ctx& p;
    struct Pre { uint2 gr[4][2], mp[4][2]; };
    static constexpr bool PAIR = true;
    template <int NA>
    __device__ __forceinline__ void prefetch(Pre& q, int rowbase, int nt, int wn, int lane) const {
        const bf16_t* GR = (const bf16_t*)(p.ws() + OFF_GR); const bf16_t* MP = (const bf16_t*)(p.ws() + OFF_H);
#pragma unroll
        for (int a = 0; a < NA; ++a)
#pragma unroll
            for (int b2 = 0; b2 < 2; ++b2) {
                const size_t o = (size_t)(rowbase + a * 16 + (lane & 15)) * D + nt * 128 + wn * 32 + b2 * 16 + 4 * (lane >> 4);
                q.gr[a][b2] = *(const uint2*)(GR + ((size_t)(nt * 8 + wn * 2 + b2) * M + rowbase + a * 16 + (lane & 15)) * 16 + 4 * (lane >> 4));
                q.mp[a][b2] = *(const uint2*)(MP + o);
            }
    }
    template <int NA>
    __device__ __forceinline__ void apply(const f32x4 (&acc)[NA][2], const Pre& q, int rowbase, int nt, int wn, int lane) const {
        bf16_t* MP = (bf16_t*)(p.ws() + OFF_H);
#pragma unroll
        for (int a = 0; a < NA; ++a)
#pragma unroll
            for (int b2 = 0; b2 < 2; ++b2) {
                const int row = rowbase + a * 16 + (lane & 15), col = nt * 128 + wn * 32 + b2 * 16 + 4 * (lane >> 4);
                const uint2 gv = q.gr[a][b2], mv = q.mp[a][b2];
                store_bf16x4(MP + (size_t)row * D + col,
                             __uint_as_float(mv.x << 16) + sigmoid_f(__uint_as_float(gv.x << 16)) * acc[a][b2][0],
                             __uint_as_float(mv.x & 0xFFFF0000u) + sigmoid_f(__uint_as_float(gv.x & 0xFFFF0000u)) * acc[a][b2][1],
                             __uint_as_float(mv.y << 16) + sigmoid_f(__uint_as_float(gv.y << 16)) * acc[a][b2][2],
                             __uint_as_float(mv.y & 0xFFFF0000u) + sigmoid_f(__uint_as_float(gv.y & 0xFFFF0000u)) * acc[a][b2][3]);
            }
    }
};
struct EpiG4 {
    const Ctx& p; int l;
    struct Pre { f32x4 x[4][2]; };
    static constexpr bool PAIR = false;
    template <int NA>
    __device__ __forceinline__ void prefetch(Pre& q, int rowbase, int nt, int wn, int lane) const {
#pragma unroll
        for (int a = 0; a < NA; ++a) {
            const float* xin = x_row_ptr(p, l, 0, rowbase + a * 16 + (lane & 15));
#pragma unroll
            for (int b2 = 0; b2 < 2; ++b2) q.x[a][b2] = *(const f32x4*)(xin + nt * 128 + wn * 32 + b2 * 16 + 4 * (lane >> 4));
        }
    }
    template <int NA>
    __device__ __forceinline__ void apply(const f32x4 (&acc)[NA][2], const Pre& q, int rowbase, int nt, int wn, int lane) const {
        const float* modv = (const float*)(p.ws() + OFF_MODV) + (size_t)l * 3 * 6144;
#pragma unroll
        for (int a = 0; a < NA; ++a) {
            const int row = rowbase + a * 16 + (lane & 15);
            float* xo = row < ML ? p.out() + (size_t)row * D : (float*)(p.ws() + OFF_XC) + (size_t)(row - ML) * D;
            const float* g1 = modv + (size_t)mod_index(row) * 6144 + 2048;
#pragma unroll
            for (int b2 = 0; b2 < 2; ++b2) {
                const int col = nt * 128 + wn * 32 + b2 * 16 + 4 * (lane >> 4);
                const f32x4 gv = *(const f32x4*)(g1 + col);
                *(f32x4*)(xo + col) = q.x[a][b2] + gv * acc[a][b2];
            }
        }
    }
};
__device__ __forceinline__ void phase_g2(const Ctx& p, int l, LAS unsigned char* lds) {
    pg8::Gemm g{(const bf16_t*)(p.ws() + OFF_YS), (const bf16_t*)(wsw(p, l) + OFF_WGLUT), ML, 2048, 512};
    pg8::StaticOrder S; S.init(ML, 2048, (int)gridDim.x, (int)blockIdx.x);
    pg8::gemm_phase(lds, g, S, EpiG2{p});
    if (l < DEPTH - 1) thin_ctx_gemm<true>(g.A, g.Bt, 512, 0, 16, EpiG2{p}, lds);
}
__device__ __forceinline__ void phase_g3(const Ctx& p, int l, LAS unsigned char* lds) {
    pg8::Gemm g{(const bf16_t*)(p.ws() + OFF_YR), (const bf16_t*)(wsw(p, l) + OFF_WRUT), ML, 1024, 512};
    pg8::StaticOrder S; S.init(ML, 1024, (int)gridDim.x, (int)blockIdx.x);
    pg8::gemm_phase(lds, g, S, EpiG3{p});
    if (l < DEPTH - 1) thin_ctx_gemm<true>(g.A, g.Bt, 512, 0, 8, EpiG3{p}, lds);
}
__device__ __forceinline__ void phase_g4(const Ctx& p, int l, LAS unsigned char* lds) {
    pg8::Gemm g{(const bf16_t*)(p.ws() + OFF_H), (const bf16_t*)(wsw(p, l) + OFF_WOUTT), ML, 1024, 1024};
    pg8::StaticOrder S; S.init(ML, 1024, (int)gridDim.x, (int)blockIdx.x);
    pg8::gemm_phase(lds, g, S, EpiG4{p, l});
    if (l < DEPTH - 1) thin_ctx_gemm<true>(g.A, g.Bt, 1024, 0, 8, EpiG4{p, l}, lds);
}

struct EpiG5 {
    const Ctx& p;
    template <int NA>
    __device__ __forceinline__ void operator()(const f32x4 (&acc)[NA][2], int rowbase, int nt, int wn, int lane) const {
        bf16_t* QP = (bf16_t*)(p.ws() + OFF_QP);
#pragma unroll
        for (int a = 0; a < NA; ++a)
#pragma unroll
            for (int b = 0; b < 2; ++b) {
                const int row = rowbase + a * 16 + (lane & 15);
                store_bf16x4(QP + ((size_t)(nt * 8 + wn * 2 + b) * M + row) * 16 + 4 * (lane >> 4), acc[a][b][0], acc[a][b][1], acc[a][b][2], acc[a][b][3]);
            }
    }
    struct Pre {};
    static constexpr bool PAIR = false;
    template <int NA> __device__ __forceinline__ void prefetch(Pre&, int, int, int, int) const {}
    template <int NA> __device__ __forceinline__ void apply(const f32x4 (&acc)[NA][2], const Pre&, int rowbase, int nt, int wn, int lane) const { this->template operator()<NA>(acc, rowbase, nt, wn, lane); }
};
__device__ __forceinline__ void phase_g5(const Ctx& p, int l, LAS unsigned char* lds) {
    pg8::Gemm g{(const bf16_t*)(p.ws() + OFF_H), (const bf16_t*)(wsw(p, l) + OFF_WQT), ML, 1024, 1024};
    pg8::StaticOrder S; S.init(ML, 1024, (int)gridDim.x, (int)blockIdx.x);
    pg8::gemm_phase(lds, g, S, EpiG5{p});
    if (l < DEPTH - 1) thin_ctx_gemm<true>(g.A, g.Bt, 1024, 0, 8, EpiG5{p}, lds);
}

__device__ __forceinline__ unsigned f2ord(float f) { const unsigned b = __float_as_uint(f); return b ^ ((b >> 31) ? 0xFFFFFFFFu : 0x80000000u); }
__device__ __forceinline__ float ord2f(unsigned o) { return __uint_as_float((o >> 31) ? (o & 0x7FFFFFFFu) : ~o); }
#define CE_DESC(a, b) do { const unsigned _x = (a), _y = (b); (a) = _x > _y ? _x : _y; (b) = _x > _y ? _y : _x; } while (0)
struct Net16 { unsigned char a[63], b[63]; };
constexpr Net16 NET16 = {{0,2,4,6,8,10,12,14,0,1,4,5,8,9,12,13,1,5,9,13,0,1,2,3,8,9,10,11,2,3,10,11,1,3,5,9,11,13,0,1,2,3,4,5,6,7,4,5,6,7,2,3,6,7,10,11,1,3,5,7,9,11,13},
                         {1,3,5,7,9,11,13,15,2,3,6,7,10,11,14,15,2,6,10,14,4,5,6,7,12,13,14,15,4,5,12,13,2,4,6,10,12,14,8,9,10,11,12,13,14,15,8,9,10,11,4,5,8,9,12,13,2,4,6,8,10,12,14}};
__device__ __forceinline__ void sort16_desc(unsigned (&v)[16]) {
#pragma unroll
    for (int t = 0; t < 63; ++t) CE_DESC(v[NET16.a[t]], v[NET16.b[t]]);
}
__device__ __forceinline__ void bitonic_merge16_desc(unsigned (&v)[16]) {
#pragma unroll
    for (int j = 8; j > 0; j >>= 1)
#pragma unroll
        for (int i = 0; i < 16; ++i) { const int l = i ^ j; if (l > i) CE_DESC(v[i], v[l]); }
}
__device__ __forceinline__ void merge_top16(unsigned (&x)[16], const unsigned (&y)[16]) {
#pragma unroll
    for (int i = 0; i < 16; ++i) x[i] = x[i] > y[15 - i] ? x[i] : y[15 - i];
    bitonic_merge16_desc(x);
}
struct CandList { int i[64], j[64], n; };
constexpr CandList make_cands() {
    CandList c{}; c.n = 0;
    for (int i = 0; i < 16; ++i) for (int j = 0; j < 16; ++j) if ((i + 1) * (j + 1) <= 16) { c.i[c.n] = i; c.j[c.n] = j; ++c.n; }
    for (int k = c.n; k < 64; ++k) { c.i[k] = -1; c.j[k] = -1; }
    return c;
}
constexpr CandList CANDS = make_cands();
static_assert(CANDS.n == 50, "candidate count");

__device__ __forceinline__ void phase_select(const Ctx& p, int l, LAS unsigned char* lds) {
    const int tid = tid_opaque(), lane = tid & 63, wid = __builtin_amdgcn_readfirstlane(tid >> 6), tok = lane & 15, fq = lane >> 4;
    const bf16_t* QP = (const bf16_t*)(p.ws() + OFF_QP); const bf16_t* SK = (const bf16_t*)(wsw(p, l) + OFF_SKEY);
    int* IDX = (int*)(p.ws() + OFF_IDX); float* GATE = (float*)(p.ws() + OFF_GATE);
    LAS unsigned* myl = (LAS unsigned*)lds + wid * 2048 + lane;
    const int gw = blockIdx.x * 8 + wid, nw = gridDim.x * 8;
    const int NFULL = ((M / 16) / nw) * nw;
    const int nrem = (l == DEPTH - 1) ? 0 : (M / 16 - NFULL) * 4;
    const int nitems = NFULL / nw + (gw < nrem ? 1 : 0) + ((gw + nw) < nrem ? 1 : 0);
#pragma unroll 1
    for (int it = 0; it < nitems; ++it) {
        int task, hp_lo, hp_hi;
        if (it < NFULL / nw) { task = it * nw + gw; hp_lo = 0; hp_hi = 4; }
        else { const int e = gw + (it - NFULL / nw) * nw; task = NFULL + (e >> 2); hp_lo = e & 3; hp_hi = hp_lo + 1; }
        const int r0 = task * 16;
        unsigned LA0[2][16], LB0[2][16];
#pragma unroll
        for (int i = 0; i < 16; ++i) { LA0[0][i] = 0u; LA0[1][i] = 0u; LB0[0][i] = 0u; LB0[1][i] = 0u; }
        const bool use_lds = it < NFULL / nw;
#pragma unroll 1
        for (int hp = hp_lo; hp < hp_hi; ++hp) {
          if (use_lds) {
              __syncthreads();
#pragma unroll 2
              for (int i = 0; i < 8; ++i) {
                  const int pc = i * NT + tid, q = pc >> 10, row = (pc >> 3) & 127, c = (pc & 7) * 8;
                  *(LAS u32x4*)(lds + 65536 + ((q * 128 + row) * 72 + c) * 2) = *(const u32x4*)(SK + (size_t)((hp * 4 + q) * 128 + row) * 64 + c);
              }
              __syncthreads();
          }
#pragma unroll
          for (int hh = 0; hh < 2; ++hh) {
            const int h = hp * 2 + hh;
#pragma unroll
            for (int s = 0; s < 2; ++s) {
                f32x4 acc[8];
#pragma unroll
                for (int n = 0; n < 8; ++n) acc[n] = (f32x4){0.f, 0.f, 0.f, 0.f};
                const bf16_t* qrow = QP + ((size_t)(h * 8 + s * 4 + (fq >> 1)) * M + r0 + tok) * 16 + (fq & 1) * 8;
                const bf16x8 a0 = *(const bf16x8*)(qrow), a1 = *(const bf16x8*)(qrow + (size_t)2 * M * 16);
                const bf16_t* kb = SK + (size_t)((h * 2 + s) * 128 + tok) * 64 + fq * 8;
                const LAS unsigned char* kl = lds + 65536 + (((hh * 2 + s) * 128 + tok) * 72 + fq * 8) * 2;
                if (use_lds) {
#pragma unroll
                    for (int n = 0; n < 8; ++n) {
                        const bf16x8 b0 = *(const LAS bf16x8*)(kl + n * 16 * 144), b1 = *(const LAS bf16x8*)(kl + n * 16 * 144 + 64);
                        acc[n] = __builtin_amdgcn_mfma_f32_16x16x32_bf16(b0, a0, acc[n], 0, 0, 0);
                        acc[n] = __builtin_amdgcn_mfma_f32_16x16x32_bf16(b1, a1, acc[n], 0, 0, 0);
                    }
                } else {
#pragma unroll
                    for (int n = 0; n < 8; ++n) {
                        const bf16x8 b0 = *(const bf16x8*)(kb + n * 16 * 64), b1 = *(const bf16x8*)(kb + n * 16 * 64 + 32);
                        acc[n] = __builtin_amdgcn_mfma_f32_16x16x32_bf16(b0, a0, acc[n], 0, 0, 0);
                        acc[n] = __builtin_amdgcn_mfma_f32_16x16x32_bf16(b1, a1, acc[n], 0, 0, 0);
                    }
                }
                unsigned x[16], y[16];
#pragma unroll
                for (int n = 0; n < 4; ++n)
#pragma unroll
                    for (int r = 0; r < 4; ++r) {
                        x[n * 4 + r] = (f2ord(acc[n][r]) & ~127u) | (unsigned)(127 - (n * 16 + fq * 4 + r));
                        y[n * 4 + r] = (f2ord(acc[n + 4][r]) & ~127u) | (unsigned)(127 - ((n + 4) * 16 + fq * 4 + r));
                    }
                sort16_desc(x); sort16_desc(y); merge_top16(x, y);
#pragma unroll
                for (int i = 0; i < 16; ++i) y[i] = (unsigned)__shfl_xor((int)x[i], 16);
                merge_top16(x, y);
#pragma unroll
                for (int i = 0; i < 16; ++i) y[i] = (unsigned)__shfl_xor((int)x[i], 32);
                merge_top16(x, y);
                if (hp == fq) {
#pragma unroll
                    for (int i = 0; i < 16; ++i) { if (s == 0) LA0[hh][i] = x[i]; else LB0[hh][i] = x[i]; }
                }
            }
          }
        }
        if (fq >= hp_lo && fq < hp_hi)
#pragma unroll
        for (int hh = 0; hh < 2; ++hh) {
            const int head = fq * 2 + hh;
            float af[16], bfv[16];
#pragma unroll
            for (int i = 0; i < 16; ++i) {
                myl[i * 64] = LA0[hh][i]; myl[(16 + i) * 64] = LB0[hh][i];
                af[i] = ord2f(LA0[hh][i] & ~127u); bfv[i] = ord2f(LB0[hh][i] & ~127u);
            }
            unsigned c[4][16];
#pragma unroll
            for (int n = 0; n < 64; ++n) {
                unsigned key = 0u;
                if (CANDS.i[n] >= 0) key = (f2ord(af[CANDS.i[n] < 0 ? 0 : CANDS.i[n]] + bfv[CANDS.j[n] < 0 ? 0 : CANDS.j[n]]) & ~255u) | (unsigned)(255 - (CANDS.i[n] * 16 + CANDS.j[n]));
                c[n >> 4][n & 15] = key;
            }
            sort16_desc(c[0]); sort16_desc(c[1]); sort16_desc(c[2]); sort16_desc(c[3]);
            merge_top16(c[0], c[1]); merge_top16(c[2], c[3]); merge_top16(c[0], c[2]);
            float sc[16], se = 0.f; int eidx[16];
#pragma unroll
            for (int k = 0; k < 16; ++k) {
                const unsigned code = 255u - (c[0][k] & 255u);
                const unsigned ka = myl[(code >> 4) * 64], kbv = myl[(16 + (code & 15u)) * 64];
                eidx[k] = (int)((127u - (ka & 127u)) * 128u + (127u - (kbv & 127u)));
                sc[k] = ord2f(c[0][k] & ~255u);
            }
            const float mx = sc[0];
#pragma unroll
            for (int k = 0; k < 16; ++k) { sc[k] = __expf(sc[k] - mx); se += sc[k]; }
            const float inv = 1.f / se;
#pragma unroll
            for (int k = 0; k < 16; ++k) sc[k] *= inv;
            int* ip = IDX + (size_t)(r0 + tok) * 128 + head * 16; float* gp = GATE + (size_t)(r0 + tok) * 128 + head * 16;
#pragma unroll
            for (int k = 0; k < 16; k += 4) { *(int4*)(ip + k) = make_int4(eidx[k], eidx[k + 1], eidx[k + 2], eidx[k + 3]); }
#pragma unroll
            for (int k = 0; k < 16; k += 4) { *(float4*)(gp + k) = make_float4(sc[k], sc[k + 1], sc[k + 2], sc[k + 3]); }
        }
    }
}

__device__ __forceinline__ u32x4 row8_load(const unsigned char* T, int idx, int lane) { return *(const u32x4*)(T + (unsigned)(idx * D + lane * 16)); }
__device__ __forceinline__ float row8_dot(const u32x4& r, const f32x2 (&hv)[8]) {
    f32x2 acc = (f32x2){0.f, 0.f};
#pragma unroll
    for (int i = 0; i < 4; ++i) {
        acc += __builtin_amdgcn_cvt_pk_f32_fp8((int)r[i], false) * hv[2 * i];
        acc += __builtin_amdgcn_cvt_pk_f32_fp8((int)r[i], true) * hv[2 * i + 1];
    }
    return acc[0] + acc[1];
}
__device__ __forceinline__ void row8_axpy(f32x2 (&o)[8], const u32x4& r, float w) {
    const f32x2 w2 = (f32x2){w, w};
#pragma unroll
    for (int i = 0; i < 4; ++i) {
        o[2 * i] += w2 * __builtin_amdgcn_cvt_pk_f32_fp8((int)r[i], false);
        o[2 * i + 1] += w2 * __builtin_amdgcn_cvt_pk_f32_fp8((int)r[i], true);
    }
}
__device__ __forceinline__ float rl_f(float v, int l) { return __uint_as_float(__builtin_amdgcn_readlane(__float_as_uint(v), l)); }
struct GTok { int i0, i1; float dv[2]; float W[2]; f32x2 o[8]; };
struct GEnv { const unsigned char* PU; const unsigned char* PV; const float* SCU; const float* SCV; const bf16_t* H; const int* IDX; const float* GATE; };
__device__ __forceinline__ void gtok_setup(GTok& t, const GEnv& e, int row, int lane, LAS unsigned* sl, LAS f32x2* hslot) {
    t.i0 = e.IDX[(size_t)row * 128 + lane]; t.i1 = e.IDX[(size_t)row * 128 + 64 + lane];
    const float su0 = e.SCU[t.i0], su1 = e.SCU[t.i1];
    const float gv0 = e.GATE[(size_t)row * 128 + lane] * e.SCV[t.i0], gv1 = e.GATE[(size_t)row * 128 + 64 + lane] * e.SCV[t.i1];
    {
        const int b0 = t.i0 >> 9, b1 = t.i1 >> 9;
        int base = 0, pos0 = 0, pos1 = 0;
#pragma unroll 4
        for (int k = 0; k < 32; ++k) {
            const unsigned long long m0 = __ballot(b0 == k), m1 = __ballot(b1 == k);
            const int c0 = __popcll(m0);
            const int r0 = __builtin_amdgcn_mbcnt_hi((unsigned)(m0 >> 32), __builtin_amdgcn_mbcnt_lo((unsigned)m0, 0u));
            const int r1 = __builtin_amdgcn_mbcnt_hi((unsigned)(m1 >> 32), __builtin_amdgcn_mbcnt_lo((unsigned)m1, 0u));
            if (b0 == k) pos0 = base + r0;
            if (b1 == k) pos1 = base + c0 + r1;
            base += c0 + __popcll(m1);
        }
        sl[pos0] = (unsigned)t.i0; sl[128 + pos0] = __float_as_uint(su0); sl[256 + pos0] = __float_as_uint(gv0);
        sl[pos1] = (unsigned)t.i1; sl[128 + pos1] = __float_as_uint(su1); sl[256 + pos1] = __float_as_uint(gv1);
        t.i0 = (int)sl[lane]; t.i1 = (int)sl[64 + lane];
    }
    const u32x4 ha = *(const u32x4*)(e.H + (size_t)row * D + lane * 16), hb = *(const u32x4*)(e.H + (size_t)row * D + lane * 16 + 8);
#pragma unroll
    for (int i = 0; i < 4; ++i) {
        hslot[i] = (f32x2){__uint_as_float(ha[i] << 16), __uint_as_float(ha[i] & 0xFFFF0000u)};
        hslot[4 + i] = (f32x2){__uint_as_float(hb[i] << 16), __uint_as_float(hb[i] & 0xFFFF0000u)};
    }
    t.dv[0] = 0.f; t.dv[1] = 0.f;
}
__device__ __forceinline__ void gtok_weights(GTok& t, int lane, const LAS unsigned* sl) {
#pragma unroll
    for (int hf = 0; hf < 2; ++hf) {
        const int ex = 64 * hf + 16 * (lane & 3) + (lane >> 2);
        const float su = __uint_as_float(sl[128 + ex]), gw = __uint_as_float(sl[256 + ex]);
        t.W[hf] = gw * gelu_erf_f(su * t.dv[hf]);
    }
}
__device__ __forceinline__ void gather_epilogue(const Ctx& p, int l, int row, int lane, const f32x2 (&o)[8], const float* modv) {
    float* xr = (row < ML ? p.out() + (size_t)row * D : (float*)(p.ws() + OFF_XC) + (size_t)(row - ML) * D) + lane * 16;
    const float* g2 = modv + (size_t)mod_index(row) * 6144 + 5120 + lane * 16;
    const float* gn = (l == DEPTH - 1) ? p.in(I_FNG) + lane * 16 : p.in(I_N1G) + (l + 1) * D + lane * 16;
    const float* mv = modv + 3 * 6144 + (size_t)mod_index(row) * 6144 + lane * 16;
    f32x4 xa[4], ga[4], gq[4], sh[4], sc[4];
#pragma unroll
    for (int i = 0; i < 4; ++i) { xa[i] = *(const f32x4*)(xr + i * 4); ga[i] = *(const f32x4*)(g2 + i * 4); gq[i] = *(const f32x4*)(gn + i * 4); }
    if (l < DEPTH - 1) {
#pragma unroll
        for (int i = 0; i < 4; ++i) { sh[i] = *(const f32x4*)(mv + i * 4); sc[i] = *(const f32x4*)(mv + 1024 + i * 4); }
    }
    f32x4 xv[4];
#pragma unroll
    for (int i = 0; i < 4; ++i) xv[i] = xa[i] + ga[i] * (f32x4){o[2 * i][0], o[2 * i][1], o[2 * i + 1][0], o[2 * i + 1][1]};
    float ss = 0.f;
#pragma unroll
    for (int i = 0; i < 4; ++i) ss += xv[i][0] * xv[i][0] + xv[i][1] * xv[i][1] + xv[i][2] * xv[i][2] + xv[i][3] * xv[i][3];
    ss = wave_sum(ss);
    const float rstd = rsqrtf(ss * (1.f / 1024.f) + EPS);
    if (l == DEPTH - 1) {
#pragma unroll
        for (int i = 0; i < 4; ++i) *(f32x4*)(xr + i * 4) = xv[i] * rstd * gq[i];
    } else {
#pragma unroll
        for (int i = 0; i < 4; ++i) *(f32x4*)(xr + i * 4) = xv[i];
        u32x4 o0, o1;
#pragma unroll
        for (int i = 0; i < 4; ++i) {
            const f32x4 hq = xv[i] * rstd * gq[i] * (sc[i] + 1.f) + sh[i];
            const unsigned w0 = pack_bf16(hq[0], hq[1]), w1 = pack_bf16(hq[2], hq[3]);
            if (i < 2) { o0[2 * i] = w0; o0[2 * i + 1] = w1; } else { o1[2 * (i - 2)] = w0; o1[2 * (i - 2) + 1] = w1; }
        }
        bf16_t* hp = (bf16_t*)(p.ws() + OFF_H) + (size_t)row * D + lane * 16;
        *(u32x4*)hp = o0; *(u32x4*)(hp + 8) = o1;
    }
}
__device__ __forceinline__ void phase_gather(const Ctx& p, int l, LAS unsigned char* glds) {
    const int tid = tid_opaque(), lane0 = tid & 63, wid = __builtin_amdgcn_readfirstlane(tid >> 6);
    GEnv e;
    e.PU = wsw(p, l) + OFF_PU; e.PV = wsw(p, l) + OFF_PV; e.SCU = (const float*)(wsw(p, l) + OFF_SCU); e.SCV = (const float*)(wsw(p, l) + OFF_SCV);
    e.H = (const bf16_t*)(p.ws() + OFF_H); e.IDX = (const int*)(p.ws() + OFF_IDX); e.GATE = (const float*)(p.ws() + OFF_GATE);
    const float* modv = (const float*)(p.ws() + OFF_MODV) + (size_t)l * 3 * 6144;
    LAS unsigned* sl = (LAS unsigned*)glds + wid * 768;
    const int gw = blockIdx.x * 8 + wid, nw = gridDim.x * 8;
    const bool balanced = (nw * 16 == ML) && (MC * 4 == nw);
    const int nitems = balanced ? (l < DEPTH - 1 ? 9 : 8) : 0;
#pragma unroll 1
    for (int it = 0; it < nitems; ++it) {
        int lane = lane0; asm volatile("" : "+v"(lane));
        const bool quarter = it == 8;
        xcd_soft_sync((unsigned*)(p.ws() + OFF_BAR), (volatile LAS unsigned*)(glds + XB_LDS_OFF), (unsigned)(l * 9 + it));
        const int rowA = quarter ? ML + (gw >> 2) : gw + (2 * it) * nw, rowB = quarter ? rowA : gw + (2 * it + 1) * nw;
        const int ng = quarter ? 1 : 8, gA0 = quarter ? 2 * (gw & 3) : 0, gB0 = quarter ? gA0 + 1 : 0;
        GTok A, B;
        LAS f32x2* hA = (LAS f32x2*)(glds + 65536) + ((wid * 2 + 0) * 64 + lane) * 8; LAS f32x2* hB = (LAS f32x2*)(glds + 65536) + ((wid * 2 + 1) * 64 + lane) * 8;
        gtok_setup(A, e, rowA, lane, sl, hA);
        __builtin_amdgcn_sched_barrier(0);
        gtok_setup(B, e, rowB, lane, sl + 384, hB);
        __builtin_amdgcn_sched_barrier(0);
        {
            u32x4 ua[4], ub[4];
            float pp[16];
#define U_LOAD(U, T, E0) { const int _is = (E0) < 64 ? T.i0 : T.i1; _Pragma("unroll") for (int j = 0; j < 4; ++j) U[j] = row8_load(e.PU, __builtin_amdgcn_readlane(_is, ((E0) + j) & 63), lane); }
#define U_DOT(U, T, O) { _Pragma("unroll") for (int j = 0; j < 4; ++j) { pp[(O) + j] = row8_dot(U[j], hvc); if (j & 1) __builtin_amdgcn_sched_barrier(0); } }
#define U_FLY(T, G) { const bool b5 = (lane & 32) != 0, b4 = (lane & 16) != 0, b3 = (lane & 8) != 0, b2 = (lane & 4) != 0; \
                float q8[8], q4[4], q2[2], q1; \
                _Pragma("unroll") for (int i = 0; i < 8; ++i) { const float keep = b5 ? pp[i + 8] : pp[i], send = b5 ? pp[i] : pp[i + 8]; q8[i] = keep + __shfl_xor(send, 32); } \
                _Pragma("unroll") for (int i = 0; i < 4; ++i) { const float keep = b4 ? q8[i + 4] : q8[i], send = b4 ? q8[i] : q8[i + 4]; q4[i] = keep + __shfl_xor(send, 16); } \
                _Pragma("unroll") for (int i = 0; i < 2; ++i) { const float keep = b3 ? q4[i + 2] : q4[i], send = b3 ? q4[i] : q4[i + 2]; q2[i] = keep + __shfl_xor(send, 8); } \
                { const float keep = b2 ? q2[1] : q2[0], send = b2 ? q2[0] : q2[1]; q1 = keep + __shfl_xor(send, 4); } \
                q1 += __shfl_xor(q1, 2); q1 += __shfl_xor(q1, 1); \
                const bool mine = (lane & 3) == ((G) & 3); \
                if ((G) < 4) T.dv[0] = mine ? q1 : T.dv[0]; else T.dv[1] = mine ? q1 : T.dv[1]; }
#define U_GROUP(T, HS, G, NEXT) { f32x2 hvc[8]; _Pragma("unroll") for (int i = 0; i < 8; ++i) hvc[i] = HS[i]; \
                U_LOAD(ub, T, (G) * 16 + 4) __builtin_amdgcn_sched_barrier(0); U_DOT(ua, T, 0) __builtin_amdgcn_sched_barrier(0); \
                U_LOAD(ua, T, (G) * 16 + 8) __builtin_amdgcn_sched_barrier(0); U_DOT(ub, T, 4) __builtin_amdgcn_sched_barrier(0); \
                U_LOAD(ub, T, (G) * 16 + 12) __builtin_amdgcn_sched_barrier(0); U_DOT(ua, T, 8) __builtin_amdgcn_sched_barrier(0); \
                NEXT __builtin_amdgcn_sched_barrier(0); U_DOT(ub, T, 12) U_FLY(T, G) }
            U_LOAD(ua, A, gA0 * 16)
#pragma unroll 1
            for (int gi = 0; gi < ng; ++gi) {
                const int gA = gA0 + gi, gB = gB0 + gi;
                U_GROUP(A, hA, gA, U_LOAD(ua, B, gB * 16))
                U_GROUP(B, hB, gB, if (gi + 1 < ng) U_LOAD(ua, A, gA * 16 + 16))
            }
#undef U_LOAD
#undef U_DOT
#undef U_FLY
#undef U_GROUP
        }
        __builtin_amdgcn_sched_barrier(0);
        gtok_weights(A, lane, sl);
        gtok_weights(B, lane, sl + 384);
        __builtin_amdgcn_sched_barrier(0);
        {
#pragma unroll
            for (int i = 0; i < 8; ++i) { A.o[i] = (f32x2){0.f, 0.f}; B.o[i] = (f32x2){0.f, 0.f}; }
            u32x4 va[4], vb[4];
#define V_LOAD(V, T, E0) { const int _is = (E0) < 64 ? T.i0 : T.i1; _Pragma("unroll") for (int j = 0; j < 4; ++j) V[j] = row8_load(e.PV, __builtin_amdgcn_readlane(_is, ((E0) + j) & 63), lane); }
#define V_ACC(V, T, E0) { const float _w = (E0) < 64 ? T.W[0] : T.W[1]; _Pragma("unroll") for (int j = 0; j < 4; ++j) { const int _e = ((E0) + j) & 63; \
                row8_axpy(T.o, V[j], rl_f(_w, ((_e & 15) << 2) | (_e >> 4))); if (j & 1) __builtin_amdgcn_sched_barrier(0); } }
#define V_GROUP(T, G, NEXT) { \
                V_LOAD(vb, T, (G) * 16 + 4) __builtin_amdgcn_sched_barrier(0); V_ACC(va, T, (G) * 16) __builtin_amdgcn_sched_barrier(0); \
                V_LOAD(va, T, (G) * 16 + 8) __builtin_amdgcn_sched_barrier(0); V_ACC(vb, T, (G) * 16 + 4) __builtin_amdgcn_sched_barrier(0); \
                V_LOAD(vb, T, (G) * 16 + 12) __builtin_amdgcn_sched_barrier(0); V_ACC(va, T, (G) * 16 + 8) __builtin_amdgcn_sched_barrier(0); \
                NEXT __builtin_amdgcn_sched_barrier(0); V_ACC(vb, T, (G) * 16 + 12) }
            V_LOAD(va, A, gA0 * 16)
#pragma unroll 1
            for (int gi = 0; gi < ng; ++gi) {
                const int gA = gA0 + gi, gB = gB0 + gi;
                V_GROUP(A, gA, V_LOAD(va, B, gB * 16))
                V_GROUP(B, gB, if (gi + 1 < ng) V_LOAD(va, A, gA * 16 + 16))
            }
#undef V_LOAD
#undef V_ACC
#undef V_GROUP
        }
        if (quarter) {
#pragma unroll
            for (int i = 0; i < 8; ++i) A.o[i] += B.o[i];
            LAS f32x2* part = (LAS f32x2*)(glds + 32768) + (wid * 64 + lane) * 8;
#pragma unroll
            for (int i = 0; i < 8; ++i) part[i] = A.o[i];
            __syncthreads();
            if ((wid & 3) != 0) continue;
#pragma unroll
            for (int q = 1; q < 4; ++q) {
                const LAS f32x2* pq = (const LAS f32x2*)(glds + 32768) + ((wid + q) * 64 + lane) * 8;
#pragma unroll
                for (int i = 0; i < 8; ++i) A.o[i] += pq[i];
            }
            gather_epilogue(p, l, rowA, lane, A.o, modv);
        } else {
            gather_epilogue(p, l, rowA, lane, A.o, modv);
            gather_epilogue(p, l, rowB, lane, B.o, modv);
        }
    }
    if (!balanced) {
        const int lane = lane0;
        for (int row = gw; row < ((l < DEPTH - 1) ? M : ML); row += nw) {
            LAS f32x2* hA = (LAS f32x2*)(glds + 65536) + ((wid * 2) * 64 + lane) * 8;
            GTok A; gtok_setup(A, e, row, lane, sl, hA);
            f32x2 hvc[8];
#pragma unroll
            for (int i = 0; i < 8; ++i) hvc[i] = hA[i];
#pragma unroll
            for (int i = 0; i < 8; ++i) A.o[i] = (f32x2){0.f, 0.f};
            for (int ee = 0; ee < 128; ++ee) {
                const int idx = __builtin_amdgcn_readlane(ee < 64 ? A.i0 : A.i1, ee & 63);
                const u32x4 ur = row8_load(e.PU, idx, lane), vr = row8_load(e.PV, idx, lane);
                float d = row8_dot(ur, hvc);
                d = wave_sum(d);
                const float w = __uint_as_float(sl[256 + ee]) * gelu_erf_f(__uint_as_float(sl[128 + ee]) * d);
                row8_axpy(A.o, vr, w);
            }
            gather_epilogue(p, l, row, lane, A.o, modv);
        }
    }
}

__device__ __forceinline__ void phase_copy_x(const Ctx& p) {
    const size_t n4 = (size_t)M * D / 4;
    for (size_t i = (size_t)blockIdx.x * NT + threadIdx.x; i < n4; i += (size_t)gridDim.x * NT) {
        const size_t e = i * 4;
        if (e < (size_t)ML * D) *(float4*)(p.out() + e) = *(const float4*)(p.in(I_X) + e);
        else *(float4*)((float*)(p.ws() + OFF_XC) + (e - (size_t)ML * D)) = *(const float4*)(p.in(I_CTX) + (e - (size_t)ML * D));
    }
}

__global__ void __launch_bounds__(NT, 2) fwd_kernel(Params kp) {
    extern __shared__ __attribute__((aligned(16))) unsigned char smem_raw[];
    LAS unsigned char* lds = (LAS unsigned char*)smem_raw;
    if (threadIdx.x == 0) *(LAS u32x4*)(lds + XB_LDS_OFF) = (u32x4){0u, 0u, 0u, 0u};
    __syncthreads();
    XcdBarrier bar = xcd_barrier_post((unsigned*)(kp.ws + OFF_BAR), (volatile LAS unsigned*)(lds + XB_LDS_OFF));
#ifdef LDS_PROBE
    {
        volatile LAS unsigned* hi = (volatile LAS unsigned*)(lds + 90000);
        if (threadIdx.x == 0) *hi = 0xABCD1234u;
        __syncthreads();
        if (threadIdx.x == 64) { const unsigned rb = *hi; if (rb != 0xABCD1234u) atomicAdd((unsigned*)(kp.ws + OFF_BAR) + 8, 1u); }
        __syncthreads();
    }
#endif

#define GRID_BARRIER() do { XcdBarrier _b = bar; asm volatile("" : "+s"(_b.bar), "+s"(_b.x)); xcd_barrier(_b); } while (0)
#ifndef PMASK
#define PMASK 0xFFFF
#endif
#ifndef REPMASK
#define REPMASK 0
#endif
#define RUN(bit, call) do { if (PMASK & (bit)) { int _reps = (REPMASK & (bit)) ? 2 : 1; if (REPMASK) asm volatile("" : "+s"(_reps)); _Pragma("unroll 1") for (int _r = 0; _r < _reps; ++_r) { call; } } } while (0)
    RUN(1, phase_modv(get_ctx(), lds));
    RUN(2, phase_prep(get_ctx(), 0, 128, lds));
    GRID_BARRIER();
    RUN(4, phase_norm(get_ctx(), 0, 0));
    GRID_BARRIER();
    for (int l = 0; l < DEPTH; ++l) {
        RUN(64, phase_g1(get_ctx(), l, lds));
        GRID_BARRIER();
        RUN(128, phase_x1(get_ctx(), l, lds));
        GRID_BARRIER();
        RUN(256, phase_x2(get_ctx(), l, lds));
        if (l + 1 < DEPTH) { RUN(2, phase_prep(get_ctx(), l + 1, 128, lds)); }
        GRID_BARRIER();
        RUN(512, phase_x3(get_ctx(), l, lds));
        GRID_BARRIER();
        RUN(1024, phase_g2(get_ctx(), l, lds));
        GRID_BARRIER();
        if (PMASK & 2048) phase_g3(get_ctx(), l, lds);
        GRID_BARRIER();
        if (PMASK & 4096) phase_g4(get_ctx(), l, lds);
        GRID_BARRIER();
        RUN(4, phase_norm(get_ctx(), l, 1));
        GRID_BARRIER();
        RUN(8, phase_g5(get_ctx(), l, lds));
        GRID_BARRIER();
        RUN(16, phase_select(get_ctx(), l, lds));
        GRID_BARRIER();
        if (PMASK & 32) phase_gather(get_ctx(), l, lds);
        GRID_BARRIER();
    }
}

extern "C" void kernel_launch(void* const* d_in, const int* in_sizes, int n_in, void* d_out, int out_size, void* d_ws, size_t ws_size,
                              hipStream_t stream) {
    static int grid = 0;
    if (!grid) {
        int dev = 0, cus = 0, per_cu = 0;
        (void)hipGetDevice(&dev);
        if (hipDeviceGetAttribute(&cus, hipDeviceAttributeMultiprocessorCount, dev) != hipSuccess || cus <= 0) cus = 256;
        if (hipFuncSetAttribute((const void*)fwd_kernel, hipFuncAttributeMaxDynamicSharedMemorySize, LDS_BYTES) != hipSuccess)
            fprintf(stderr, "kernel_launch: hipFuncSetAttribute failed\n");
        if (hipOccupancyMaxActiveBlocksPerMultiprocessor(&per_cu, (const void*)fwd_kernel, NT, LDS_BYTES) != hipSuccess || per_cu < 1)
            fprintf(stderr, "kernel_launch: note: occupancy query reports %d workgroups per CU\n", per_cu);
        (void)hipGetLastError();
        grid = 256;
        if (cus != 256) fprintf(stderr, "kernel_launch: note: device reports %d CUs; the kernel is laid out for 256\n", cus);
        if (ws_size < WS_TOTAL) fprintf(stderr, "kernel_launch: workspace too small: %zu < %zu\n", ws_size, (size_t)WS_TOTAL);
    }
    (void)hipMemsetAsync((unsigned char*)d_ws + OFF_BAR, 0, 16384, stream);
    Params p{};
    for (int i = 0; i < 30; ++i) p.in[i] = (const float*)d_in[i];
    p.out = (float*)d_out; p.ws = (unsigned char*)d_ws;
    fwd_kernel<<<dim3(grid), dim3(NT), LDS_BYTES, stream>>>(p);
}
```

```cpp
#include <hip/hip_runtime.h>
#include <stdint.h>
#include <stdio.h>

#define ENABLE_PEER 1

#define LAS __attribute__((address_space(3)))
typedef unsigned short bf16_t;
typedef short bf16x8 __attribute__((ext_vector_type(8)));
typedef float f32x4 __attribute__((ext_vector_type(4)));
typedef __bf16 bf16x2 __attribute__((ext_vector_type(2)));
typedef unsigned u32x4 __attribute__((ext_vector_type(4)));
typedef unsigned u32x2 __attribute__((ext_vector_type(2)));
typedef float f32x2 __attribute__((ext_vector_type(2)));

constexpr int D = 1024, NB = 2, SEQ = 16384, CTX = 256, DEPTH = 4;
constexpr int ML = NB * SEQ, MC = NB * CTX, M = ML + MC;
constexpr int TS = SEQ + CTX;
constexpr int INC = 4608;
constexpr int NEXP = 16384;
constexpr float EPS = 1e-6f;
constexpr int NT = 512;

enum { I_X = 0, I_C, I_CTX, I_CCTX, I_WMOD, I_BMOD, I_N1G, I_N2G, I_WIN, I_BRE, I_BIM, I_CRE, I_CIM, I_SSMD, I_LREF, I_LIMF, I_LDTF,
       I_LREB, I_LIMB, I_LDTB, I_WGLU, I_RDF, I_RDB, I_WRU, I_WOUT, I_WQ, I_SKEY, I_PU, I_PV, I_FNG };

struct Params { const float* in[30]; float* out; unsigned char* ws; };
#define AS4 __attribute__((address_space(4)))
struct Ctx {
    const AS4 unsigned long long* ka;
    __device__ __forceinline__ const float* in(int i) const { return (const float*)(const __attribute__((address_space(1))) float*)ka[i]; }
    __device__ __forceinline__ float* out() const { return (float*)(__attribute__((address_space(1))) float*)ka[30]; }
    __device__ __forceinline__ unsigned char* ws() const { return (unsigned char*)(__attribute__((address_space(1))) unsigned char*)ka[31]; }
};
__device__ __forceinline__ unsigned char* wsw(const Ctx& p, int l);
__device__ __forceinline__ Ctx get_ctx() {
    const AS4 unsigned long long* ka = (const AS4 unsigned long long*)__builtin_amdgcn_kernarg_segment_ptr();
    asm volatile("" : "+s"(ka));
    return Ctx{ka};
}

constexpr size_t al(size_t x) { return (x + 4095) & ~(size_t)4095; }
constexpr size_t OFF_BAR   = 0;
constexpr size_t OFF_MODV  = 16384;
constexpr size_t OFF_ROPE  = al(OFF_MODV + (size_t)4 * 3 * 6144 * 4);
constexpr size_t OFF_S5AT  = al(OFF_ROPE + (size_t)(256 * 32 * 2 + 64 * 32 * 2) * 4);
constexpr size_t OFF_SCU   = al(OFF_S5AT + (size_t)32 * 2 * 64 * 2 * 4);
constexpr size_t OFF_SCV   = al(OFF_SCU + (size_t)NEXP * 4);
constexpr size_t OFF_WINT  = al(OFF_SCV + (size_t)NEXP * 4);
constexpr size_t OFF_WGLUT = al(OFF_WINT + (size_t)INC * D * 2);
constexpr size_t OFF_WRUT  = al(OFF_WGLUT + (size_t)2048 * 512 * 2);
constexpr size_t OFF_WOUTT = al(OFF_WRUT + (size_t)1024 * 512 * 2);
constexpr size_t OFF_WQT   = al(OFF_WOUTT + (size_t)D * D * 2);
constexpr size_t OFF_SKEY  = al(OFF_WQT + (size_t)D * D * 2);
constexpr size_t OFF_PU    = al(OFF_SKEY + (size_t)16 * 128 * 64 * 2);
constexpr size_t OFF_PV    = al(OFF_PU + (size_t)NEXP * D);
constexpr size_t OFF_S5W   = al(OFF_PV + (size_t)NEXP * D);
constexpr size_t OFF_S5TV  = al(OFF_S5W + (size_t)32 * 256 * 512 * 2);
constexpr size_t WBLK      = al(OFF_S5TV + (size_t)32 * 512 * 768 * 2) - OFF_S5AT;
constexpr size_t OFF_XC    = OFF_S5AT + 2 * WBLK;
constexpr size_t OFF_H     = al(OFF_XC + (size_t)MC * D * 4);
constexpr size_t OFF_U     = al(OFF_H + (size_t)M * D * 2);
constexpr size_t OFF_Q     = al(OFF_U + (size_t)M * 512 * 2);
constexpr size_t OFF_K     = al(OFF_Q + (size_t)M * 512 * 2);
constexpr size_t OFF_G     = al(OFF_K + (size_t)M * 512 * 2);
constexpr size_t OFF_KTF   = al(OFF_G + (size_t)M * 512 * 2);
constexpr size_t OFF_KTB   = al(OFF_KTF + (size_t)NB * 4 * 128 * TS * 2);
constexpr size_t OFF_VT    = al(OFF_KTB + (size_t)NB * 4 * 128 * TS * 2);
constexpr size_t OFF_GS    = al(OFF_VT + (size_t)NB * 4 * 128 * TS * 2);
constexpr size_t OFF_GR    = al(OFF_GS + (size_t)M * D * 2);
constexpr size_t OFF_SBUF  = al(OFF_GR + (size_t)M * D * 2);
constexpr size_t OFF_HIN   = al(OFF_SBUF + (size_t)32 * 1040 * 256 * 4);
constexpr size_t OFF_YS    = al(OFF_HIN + (size_t)32 * 1040 * 256 * 2);
constexpr size_t OFF_KV    = al(OFF_YS + (size_t)M * 512 * 2);
constexpr size_t OFF_SBEF  = al(OFF_KV + (size_t)NB * 4 * 2 * 130 * 16384 * 2);
constexpr size_t OFF_YR    = al(OFF_SBEF + (size_t)NB * 4 * 2 * 130 * 16384 * 2);
constexpr size_t OFF_PBUF  = al(OFF_YR + (size_t)M * 512 * 2);
constexpr size_t OFF_AS5   = al(OFF_PBUF + (size_t)256 * 128 * 128 * 2);
constexpr size_t WS_TOTAL  = al(OFF_AS5 + (size_t)32 * 1040 * 768 * 2);
constexpr size_t OFF_QP    = OFF_GS;
constexpr size_t OFF_IDX   = OFF_GR;
constexpr size_t OFF_GATE  = OFF_GR + (size_t)M * 128 * 4;

__device__ __forceinline__ unsigned char* wsw(const Ctx& p, int l) { return p.ws() + (size_t)(l & 1) * WBLK; }
__device__ __forceinline__ float bf2f(unsigned short u) { return __uint_as_float(((unsigned)u) << 16); }
__device__ __forceinline__ unsigned pack_bf16(float lo, float hi) { bf16x2 v; v[0] = (__bf16)lo; v[1] = (__bf16)hi; return __builtin_bit_cast(unsigned, v); }
__device__ __forceinline__ float wave_sum(float v) {
#pragma unroll
    for (int o = 32; o > 0; o >>= 1) v += __shfl_xor(v, o);
    return v;
}
__device__ __forceinline__ float rcp_f(float v) { return __builtin_amdgcn_rcpf(v); }
__device__ __forceinline__ float silu_f(float v) { return v * rcp_f(1.f + __expf(-v)); }
__device__ __forceinline__ float sigmoid_f(float v) { return rcp_f(1.f + __expf(-v)); }
__device__ __forceinline__ float gelu_tanh_f(float v) { const float u = 0.7978845608028654f * (v + 0.044715f * v * v * v); return v * rcp_f(1.f + __expf(-2.f * u)); }
__device__ __forceinline__ float gelu_erf_f(float v) { return 0.5f * v * (1.f + erff(v * 0.7071067811865476f)); }
__device__ __forceinline__ float dot2bf(unsigned a, unsigned b, float c) { return __builtin_amdgcn_fdot2_f32_bf16(__builtin_bit_cast(bf16x2, a), __builtin_bit_cast(bf16x2, b), c, false); }
__device__ __forceinline__ int tid_opaque() { int t = threadIdx.x; asm volatile("" : "+v"(t)); return t; }
__device__ __forceinline__ int mod_index(int row) { return row < ML ? (row >> 14) : 2; }

#define XB_TMO      128
#define XB_XCNT(j)  (256  + 64 * (j))
#define XB_XSUB(j)  (1280 + 64 * (j))
#define XB_XGEN(j)  (2304 + 64 * (j))
#define XB_TOP      3328
#define XB_TOPGEN   3392
#define XCD_BAR_WORDS 3456
#define XB_SPIN_CAP (1u << 18)

typedef __attribute__((address_space(1))) unsigned gu32;
__device__ __forceinline__ unsigned xb_ld(unsigned* p)              { return __hip_atomic_load((gu32*)p, __ATOMIC_RELAXED, __HIP_MEMORY_SCOPE_AGENT); }
__device__ __forceinline__ unsigned xb_add(unsigned* p, unsigned v) { return __hip_atomic_fetch_add((gu32*)p, v, __ATOMIC_RELAXED, __HIP_MEMORY_SCOPE_AGENT); }
__device__ __forceinline__ unsigned xb_xcc_id() { return (unsigned)__builtin_amdgcn_s_getreg((3 << 11) | 20) & 0xFu; }
#define XB_SPIN(cond, bar) do { unsigned _sp = 0; while (cond) { __builtin_amdgcn_s_sleep(1); \
    if ((++_sp & 255u) == 0u) { if (xb_ld(&(bar)[XB_TMO])) break; if (_sp > XB_SPIN_CAP) { atomicAdd(&(bar)[XB_TMO], 1u); break; } } } } while (0)

struct XcdBarrier { unsigned* bar; unsigned x; volatile LAS unsigned* st; };

__device__ __forceinline__ XcdBarrier xcd_barrier_post(unsigned* bar, volatile LAS unsigned* st) {
    XcdBarrier b; b.bar = bar; b.x = xb_xcc_id(); b.st = st;
    if (threadIdx.x == 0) (void)xb_add(&bar[XB_XCNT(b.x)], 1u);
    return b;
}
__device__ __forceinline__ void xcd_barrier_complete(unsigned* bar, unsigned x, unsigned& nloc, unsigned& nx) {
    const unsigned G = gridDim.x * gridDim.y * gridDim.z;
    unsigned sum, cnt, mine, sp = 0u;
    for (;;) {
        sum = 0u; cnt = 0u; mine = 0u;
#pragma unroll
        for (unsigned j = 0; j < 16; ++j) { const unsigned c = xb_ld(&bar[XB_XCNT(j)]); sum += c; cnt += (c > 0u) ? 1u : 0u; mine = (j == x) ? c : mine; }
        if (sum == G) break;
        __builtin_amdgcn_s_sleep(1);
        if ((++sp & 255u) == 0u) { if (xb_ld(&bar[XB_TMO])) break; if (sp > XB_SPIN_CAP) { atomicAdd(&bar[XB_TMO], 1u); break; } }
    }
    nloc = mine > 0u ? mine : 1u; nx = cnt > 0u ? cnt : 1u;
}
__device__ __forceinline__ void xcd_barrier(const XcdBarrier& b) {
    asm volatile("s_waitcnt vmcnt(0)" ::: "memory");
    __syncthreads();
    if (threadIdx.x == 0) {
        unsigned* bar = b.bar;
        __builtin_amdgcn_s_waitcnt(0);
        unsigned nloc = b.st[0], nx = b.st[1];
        if (nloc == 0u) { xcd_barrier_complete(bar, b.x, nloc, nx); b.st[0] = nloc; b.st[1] = nx; }
        const unsigned old = xb_add(&bar[XB_XSUB(b.x)], 1u);
        const unsigned gen = old / nloc;
        if (old + 1u == (gen + 1u) * nloc) {
            __builtin_amdgcn_fence(__ATOMIC_RELEASE, "agent");
            asm volatile("s_waitcnt vmcnt(0)" ::: "memory");
            const unsigned og = xb_add(&bar[XB_TOP], 1u);
            const unsigned tg = og / nx;
            if (og + 1u == (tg + 1u) * nx) xb_add(&bar[XB_TOPGEN], 1u);
            else XB_SPIN(xb_ld(&bar[XB_TOPGEN]) == tg, bar);
            __builtin_amdgcn_fence(__ATOMIC_ACQUIRE, "agent");
            xb_add(&bar[XB_XGEN(b.x)], 1u);
            asm volatile("s_waitcnt vmcnt(0)" ::: "memory");
        } else {
            XB_SPIN(xb_ld(&bar[XB_XGEN(b.x)]) == gen, bar);
            __builtin_amdgcn_fence(__ATOMIC_ACQUIRE, "agent");
            asm volatile("s_waitcnt vmcnt(0)" ::: "memory");
        }
    }
    __syncthreads();
}


#define GS_CNT(j) (3520 + 64 * ((j) & 7))
#ifndef SOFT_SYNC
#define SOFT_SYNC 1
#endif
__device__ __forceinline__ void xcd_soft_sync(unsigned* bar, volatile LAS unsigned* st, unsigned step) {
#if SOFT_SYNC
    if (threadIdx.x == 0) {
        const unsigned x = xb_xcc_id(), nloc = st[0];
        if (nloc != 0u) {
            const unsigned target = nloc * (step + 1u);
            (void)xb_add(&bar[GS_CNT(x)], 1u);
            for (int sp = 0; sp < 4000; ++sp) { if (xb_ld(&bar[GS_CNT(x)]) >= target) break; __builtin_amdgcn_s_sleep(2); }
        }
    }
    __syncthreads();
#endif
}
constexpr int LROW = 72;
constexpr int TILE_LDS = 128 * LROW * 2;
constexpr int MMA_LDS = 4 * TILE_LDS;
constexpr int LDS_BYTES = 147456;
constexpr int XB_LDS_OFF = LDS_BYTES - 16;
constexpr int PP = 136;
constexpr int P_LDS_OFF = MMA_LDS;
constexpr int RED_LDS_OFF = P_LDS_OFF + 128 * PP * 2;

template <bool SW, bool ALDS, class LA, class LB>
__device__ __forceinline__ void mma_tile_g(f32x4 (&acc)[4][2], const LA& la, const LB& lb, const int K, LAS unsigned char* lds) {
    const int tid = tid_opaque(), lane = tid & 63, wid = __builtin_amdgcn_readfirstlane(tid >> 6), wm = wid >> 2, wn = wid & 3;
    const int lr = tid >> 3, lk = (tid & 7) * 8;
    const int nkt = K >> 6;
    u32x4 ra0, ra1, rb0, rb1;
    if (!ALDS) { ra0 = *(const u32x4*)la(lr, lk); ra1 = *(const u32x4*)la(lr + 64, lk); }
    rb0 = *(const u32x4*)lb(lr, lk); rb1 = *(const u32x4*)lb(lr + 64, lk);
    const int woff = (lr * LROW + lk) * 2;
    {
        LAS unsigned char* Ab = lds; LAS unsigned char* Bb = lds + TILE_LDS;
        if (!ALDS) { *(LAS u32x4*)(Ab + woff) = ra0; *(LAS u32x4*)(Ab + woff + 64 * LROW * 2) = ra1; }
        *(LAS u32x4*)(Bb + woff) = rb0; *(LAS u32x4*)(Bb + woff + 64 * LROW * 2) = rb1;
    }
    __syncthreads();
    const int aoff = ALDS ? P_LDS_OFF + ((wm * 64 + (lane & 15)) * PP + (lane >> 4) * 8) * 2 : ((wm * 64 + (lane & 15)) * LROW + (lane >> 4) * 8) * 2;
    const int boff = ((wn * 32 + (lane & 15)) * LROW + (lane >> 4) * 8) * 2;
    for (int kt = 0; kt < nkt; ++kt) {
        const bool more = (kt + 1 < nkt);
        if (more) {
            const int k = (kt + 1) * 64 + lk;
            if (!ALDS) { ra0 = *(const u32x4*)la(lr, k); ra1 = *(const u32x4*)la(lr + 64, k); }
            rb0 = *(const u32x4*)lb(lr, k); rb1 = *(const u32x4*)lb(lr + 64, k);
        }
        LAS unsigned char* Ab = lds + (kt & 1) * 2 * TILE_LDS; LAS unsigned char* Bb = Ab + TILE_LDS;
#pragma unroll
        for (int ks = 0; ks < 2; ++ks) {
            bf16x8 af[4], bfr[2];
#pragma unroll
            for (int mt = 0; mt < 4; ++mt)
                af[mt] = ALDS ? *(const LAS bf16x8*)(lds + aoff + (mt * 16 * PP + kt * 64 + ks * 32) * 2)
                              : *(const LAS bf16x8*)(Ab + aoff + (mt * 16 * LROW + ks * 32) * 2);
#pragma unroll
            for (int nt = 0; nt < 2; ++nt) bfr[nt] = *(const LAS bf16x8*)(Bb + boff + (nt * 16 * LROW + ks * 32) * 2);
#pragma unroll
            for (int mt = 0; mt < 4; ++mt)
#pragma unroll
                for (int nt = 0; nt < 2; ++nt)
                    acc[mt][nt] = SW ? __builtin_amdgcn_mfma_f32_16x16x32_bf16(bfr[nt], af[mt], acc[mt][nt], 0, 0, 0)
                                     : __builtin_amdgcn_mfma_f32_16x16x32_bf16(af[mt], bfr[nt], acc[mt][nt], 0, 0, 0);
        }
        if (more) {
            LAS unsigned char* An = lds + ((kt + 1) & 1) * 2 * TILE_LDS; LAS unsigned char* Bn = An + TILE_LDS;
            if (!ALDS) { *(LAS u32x4*)(An + woff) = ra0; *(LAS u32x4*)(An + woff + 64 * LROW * 2) = ra1; }
            *(LAS u32x4*)(Bn + woff) = rb0; *(LAS u32x4*)(Bn + woff + 64 * LROW * 2) = rb1;
        }
        __syncthreads();
    }
}
template <bool SW, class LA, class LB>
__device__ __forceinline__ void mma_tile(f32x4 (&acc)[4][2], const LA& la, const LB& lb, const int K, LAS unsigned char* lds) {
    mma_tile_g<SW, false>(acc, la, lb, K, lds);
}
__device__ __forceinline__ void zero_acc(f32x4 (&acc)[4][2]) {
#pragma unroll
    for (int a = 0; a < 4; ++a)
#pragma unroll
        for (int b = 0; b < 2; ++b) acc[a][b] = (f32x4){0.f, 0.f, 0.f, 0.f};
}
__device__ __forceinline__ void tile_coords(int id, int nMt, int nNt, int& mt, int& nt) {
    const int per = 16 * nNt, g = id / per, r = id % per, m0 = g * 16, gm = (nMt - m0) < 16 ? (nMt - m0) : 16;
    mt = m0 + r % gm; nt = r / gm;
}


namespace pg8 {
constexpr int BM = 256, BK = 64, HALF = 128, HTB = HALF * BK * 2, STAGE_BYTES = 8 * HTB, NXCD = 8, WGM = 4;
__device__ __forceinline__ int lds_byte(int r, int c) { const int st = (r >> 4) * 2 + (c >> 5), rr = r & 15, cc = c & 31, ob = rr * 64 + cc * 2; return st * 1024 + (ob ^ (((ob >> 9) & 1) << 5)); }
__device__ __forceinline__ void stage_rc(int b, int& R, int& C) { const int st = b / 1024, sb = b % 1024, swz = sb ^ (((sb >> 9) & 1) << 5); R = (st >> 1) * 16 + swz / 64; C = (st & 1) * 32 + (swz % 64) / 2; }
struct Unit { int pm, pn; };
struct Gemm { const bf16_t* A; const bf16_t* Bt; int M, N, K; };
struct StaticOrder {
    int nM, nN, nwg, G, c;
    __device__ void init(int M_, int N_, int G_, int c_) { nM = M_ / BM; nN = N_ / BM; nwg = nM * nN; G = G_; c = c_; }
    __device__ bool next(int i, Unit& u) const {
        const long L = (long)i * G + c; if (L >= nwg) return false;
        int wgid = (int)L; { const int q = nwg / NXCD, r = nwg % NXCD, xcd = wgid % NXCD, off = wgid / NXCD; wgid = (xcd < r ? xcd * (q + 1) : r * (q + 1) + (xcd - r) * q) + off; }
        const int nig = WGM * nN, gid = wgid / nig, fm = gid * WGM, gsz = (nM - fm) < WGM ? (nM - fm) : WGM;
        u.pm = fm + ((wgid % nig) % gsz); u.pn = (wgid % nig) / gsz; return true;
    }
    __device__ __forceinline__ const char* abase(const Gemm& g, const Unit& u) const { return (const char*)g.A + (size_t)u.pm * ((size_t)BM * g.K * 2); }
    __device__ __forceinline__ const char* bbase(const Gemm& g, const Unit& u) const { return (const char*)g.Bt + (size_t)u.pn * ((size_t)BM * g.K * 2); }
};
template <class Epi, class Sched>
__device__ __forceinline__ void gemm_phase(LAS unsigned char* lds, const Gemm g, const Sched& S, const Epi& E) {
    const int tid = tid_opaque(), wid = __builtin_amdgcn_readfirstlane(tid >> 6), lane = tid & 63, wr = wid >> 2, wc = wid & 3, fr = lane & 15, fq = lane >> 4;
    const int K = g.K, nt = K / BK;
    unsigned voffA[2], voffB[2];
#pragma unroll
    for (int i = 0; i < 2; ++i) { int R, C; stage_rc(tid * 16 + i * 8192, R, C); voffA[i] = (unsigned)(R * K + C) * 2u; voffB[i] = voffA[i]; }
    const size_t kstep = (size_t)(BK * 2);
    const size_t hstep = (size_t)HALF * K * 2;
    const unsigned ldsw = (unsigned)wid * 1024u;
    const int aoff = lds_byte(wr * 64 + fr, fq * 8), boff = lds_byte(wc * 32 + fr, fq * 8);
#define PG8_SA(b, h) (((b) * 2 + (h)) * HTB)
#define PG8_SB(b, h) ((4 + (b) * 2 + (h)) * HTB)
#define PG8_STAGE(bufoff, gbase, voff) do { _Pragma("unroll") for (int _i = 0; _i < 2; ++_i) \
        __builtin_amdgcn_global_load_lds((const unsigned*)((const char*)(gbase) + (voff)[_i]), (LAS unsigned*)(lds + (bufoff) + ldsw + _i * 8192), 16, 0, 0); } while (0)
#define PG8_LDA(dst, b, h) do { _Pragma("unroll") for (int m = 0; m < 4; ++m) _Pragma("unroll") for (int k = 0; k < 2; ++k) dst[m][k] = *(const LAS bf16x8*)(lds + PG8_SA(b, h) + aoff + m * 2048 + k * 1024); } while (0)
#define PG8_LDB(dst, b, h) do { _Pragma("unroll") for (int n = 0; n < 2; ++n) _Pragma("unroll") for (int k = 0; k < 2; ++k) dst[n][k] = *(const LAS bf16x8*)(lds + PG8_SB(b, h) + boff + n * 2048 + k * 1024); } while (0)
#define PG8_MMA(ai, bj, At, Bt) do { __builtin_amdgcn_s_setprio(1); _Pragma("unroll") for (int m = 0; m < 4; ++m) _Pragma("unroll") for (int n = 0; n < 2; ++n) _Pragma("unroll") for (int k = 0; k < 2; ++k) \
        acc[ai][bj][m][n] = __builtin_amdgcn_mfma_f32_16x16x32_bf16(Bt[n][k], At[m][k], acc[ai][bj][m][n], 0, 0, 0); __builtin_amdgcn_s_setprio(0); } while (0)
#define PG8_WAIT_V(n) asm volatile("s_waitcnt vmcnt(" #n ")" ::: "memory")
#define PG8_WAIT_L(n) asm volatile("s_waitcnt lgkmcnt(" #n ")" ::: "memory")
#define PG8_BAR __builtin_amdgcn_s_barrier()
#define PG8_SCHED __builtin_amdgcn_sched_barrier(0)
    Unit cur, nxt; int ui = 0;
    if (!S.next(0, cur)) return;
    f32x4 acc[2][2][4][2];
#pragma unroll
    for (int a = 0; a < 2; ++a)
#pragma unroll
        for (int b = 0; b < 2; ++b)
#pragma unroll
            for (int m = 0; m < 4; ++m)
#pragma unroll
                for (int n = 0; n < 2; ++n) acc[a][b][m][n] = (f32x4){0.f, 0.f, 0.f, 0.f};
    bf16x8 At[4][2], B0[2][2], B1[2][2];
    const char* cA = S.abase(g, cur); const char* cB = S.bbase(g, cur);
    PG8_STAGE(PG8_SB(0, 0), cB, voffB); PG8_STAGE(PG8_SA(0, 0), cA, voffA); PG8_STAGE(PG8_SB(0, 1), cB + hstep, voffB); PG8_STAGE(PG8_SA(0, 1), cA + hstep, voffA);
    if (wr == 1) PG8_BAR;
    PG8_WAIT_V(4); PG8_BAR;
    PG8_STAGE(PG8_SB(1, 0), cB + kstep, voffB); PG8_STAGE(PG8_SA(1, 0), cA + kstep, voffA); PG8_STAGE(PG8_SB(1, 1), cB + hstep + kstep, voffB);
    PG8_WAIT_V(6); PG8_BAR;
    for (;;) {
        const bool has_next = S.next(ui + 1, nxt);
        const char* nA = has_next ? S.abase(g, nxt) : cA; const char* nB = has_next ? S.bbase(g, nxt) : cB;
        for (int t = 0; t < nt; t += 2) {
            const bool last = (t == nt - 2);
            const char* a1 = cA + (size_t)(t + 1) * kstep;
            const char* a2 = last ? nA : cA + (size_t)(t + 2) * kstep; const char* b2 = last ? nB : cB + (size_t)(t + 2) * kstep;
            const char* a3 = a2 + kstep; const char* b3 = b2 + kstep;
            PG8_LDB(B0, 0, 0); PG8_SCHED; PG8_LDA(At, 0, 0); PG8_STAGE(PG8_SA(1, 1), a1 + hstep, voffA);
            PG8_WAIT_L(8); PG8_BAR; PG8_WAIT_L(0); PG8_MMA(0, 0, At, B0); PG8_BAR; PG8_SCHED;
            PG8_LDB(B1, 0, 1); PG8_STAGE(PG8_SB(0, 0), b2, voffB);
            PG8_BAR; PG8_WAIT_L(0); PG8_MMA(0, 1, At, B1); PG8_BAR;
            PG8_LDA(At, 0, 1); PG8_STAGE(PG8_SA(0, 0), a2, voffA);
            PG8_BAR; PG8_WAIT_L(0); PG8_MMA(1, 0, At, B0); PG8_BAR; PG8_SCHED;
            PG8_STAGE(PG8_SB(0, 1), b2 + hstep, voffB);
            PG8_WAIT_V(6); PG8_BAR; PG8_MMA(1, 1, At, B1); PG8_BAR;
            PG8_LDB(B0, 1, 0); PG8_SCHED; PG8_LDA(At, 1, 0); PG8_STAGE(PG8_SA(0, 1), a2 + hstep, voffA);
            PG8_WAIT_L(8); PG8_BAR; PG8_WAIT_L(0); PG8_MMA(0, 0, At, B0); PG8_BAR; PG8_SCHED;
            PG8_LDB(B1, 1, 1); PG8_STAGE(PG8_SB(1, 0), b3, voffB);
            PG8_BAR; PG8_WAIT_L(0); PG8_MMA(0, 1, At, B1); PG8_BAR;
            PG8_LDA(At, 1, 1); PG8_STAGE(PG8_SA(1, 0), a3, voffA);
            PG8_BAR; PG8_WAIT_L(0); PG8_MMA(1, 0, At, B0); PG8_BAR; PG8_SCHED;
            PG8_STAGE(PG8_SB(1, 1), b3 + hstep, voffB);
            PG8_WAIT_V(6); PG8_BAR; PG8_MMA(1, 1, At, B1); PG8_BAR;
        }
#pragma unroll
        for (int ai = 0; ai < 2; ++ai) {
            if constexpr (Epi::PAIR) {
                typename Epi::Pre pre[2];
#pragma unroll
                for (int bj = 0; bj < 2; ++bj) E.template prefetch<4>(pre[bj], (cur.pm * 2 + ai) * 128 + wr * 64, cur.pn * 2 + bj, wc, lane);
#pragma unroll
                for (int bj = 0; bj < 2; ++bj) E.template apply<4>(acc[ai][bj], pre[bj], (cur.pm * 2 + ai) * 128 + wr * 64, cur.pn * 2 + bj, wc, lane);
            } else {
#pragma unroll
                for (int bj = 0; bj < 2; ++bj) {
                    typename Epi::Pre pre;
                    E.template prefetch<4>(pre, (cur.pm * 2 + ai) * 128 + wr * 64, cur.pn * 2 + bj, wc, lane);
                    E.template apply<4>(acc[ai][bj], pre, (cur.pm * 2 + ai) * 128 + wr * 64, cur.pn * 2 + bj, wc, lane);
                }
            }
        }
        if (!has_next) break;
#pragma unroll
        for (int a = 0; a < 2; ++a)
#pragma unroll
            for (int b = 0; b < 2; ++b)
#pragma unroll
                for (int m = 0; m < 4; ++m)
#pragma unroll
                    for (int n = 0; n < 2; ++n) acc[a][b][m][n] = (f32x4){0.f, 0.f, 0.f, 0.f};
        cur = nxt; cA = nA; cB = nB; ++ui;
    }
    PG8_WAIT_V(0);
    if (wr == 0) PG8_BAR;
    PG8_BAR;
#undef PG8_SA
#undef PG8_SB
#undef PG8_STAGE
#undef PG8_LDA
#undef PG8_LDB
#undef PG8_MMA
#undef PG8_WAIT_V
#undef PG8_WAIT_L
#undef PG8_BAR
#undef PG8_SCHED
}
}

template <class LA, class LB>
__device__ __forceinline__ void mma_tile_dma(f32x4 (&acc)[4][2], const LA& la, const LB& lb, const int K, LAS unsigned char* lds) {
    using pg8::HTB; using pg8::lds_byte; using pg8::stage_rc;
    const int tid = tid_opaque(), lane = tid & 63, wid = __builtin_amdgcn_readfirstlane(tid >> 6), wm = wid >> 2, wn = wid & 3, fr = lane & 15, fq = lane >> 4;
    const int nkt = K >> 6;
    int sR[2], sC[2];
#pragma unroll
    for (int i = 0; i < 2; ++i) stage_rc(tid * 16 + i * 8192, sR[i], sC[i]);
    const unsigned ldsw = (unsigned)wid * 1024u;
    const int aoff = lds_byte(wm * 64 + fr, fq * 8), boff = lds_byte(wn * 32 + fr, fq * 8);
#define TD_STAGE(kt_) do { const int _s = (kt_) & 3; _Pragma("unroll") for (int _i = 0; _i < 2; ++_i) { \
        __builtin_amdgcn_global_load_lds((const unsigned*)la(sR[_i], (kt_) * 64 + sC[_i]), (LAS unsigned*)(lds + _s * 2 * HTB + ldsw + _i * 8192), 16, 0, 0); \
        __builtin_amdgcn_global_load_lds((const unsigned*)lb(sR[_i], (kt_) * 64 + sC[_i]), (LAS unsigned*)(lds + _s * 2 * HTB + HTB + ldsw + _i * 8192), 16, 0, 0); } } while (0)
    TD_STAGE(0);
    if (nkt > 1) TD_STAGE(1);
    if (nkt > 2) TD_STAGE(2);
    for (int kt = 0; kt < nkt; ++kt) {
        const int ahead = nkt - 1 - kt;
        if (ahead >= 2) asm volatile("s_waitcnt vmcnt(8)" ::: "memory");
        else if (ahead == 1) asm volatile("s_waitcnt vmcnt(4)" ::: "memory");
        else asm volatile("s_waitcnt vmcnt(0)" ::: "memory");
        __builtin_amdgcn_s_barrier();
        asm volatile("" ::: "memory");
        if (kt + 3 < nkt) TD_STAGE(kt + 3);
        const LAS unsigned char* Ab = lds + (kt & 3) * 2 * HTB; const LAS unsigned char* Bb = Ab + HTB;
#pragma unroll
        for (int ks = 0; ks < 2; ++ks) {
            bf16x8 af[4], bfr[2];
#pragma unroll
            for (int mt = 0; mt < 4; ++mt) af[mt] = *(const LAS bf16x8*)(Ab + aoff + mt * 2048 + ks * 1024);
#pragma unroll
            for (int nt = 0; nt < 2; ++nt) bfr[nt] = *(const LAS bf16x8*)(Bb + boff + nt * 2048 + ks * 1024);
#pragma unroll
            for (int mt = 0; mt < 4; ++mt)
#pragma unroll
                for (int nt = 0; nt < 2; ++nt) acc[mt][nt] = __builtin_amdgcn_mfma_f32_16x16x32_bf16(bfr[nt], af[mt], acc[mt][nt], 0, 0, 0);
        }
    }
    asm volatile("s_waitcnt lgkmcnt(0)" ::: "memory");
    __builtin_amdgcn_s_barrier();
    asm volatile("" ::: "memory");
#undef TD_STAGE
}

template <int NKT, class IdFn, class LdFn, class EpFn>
__device__ __forceinline__ void tile_stream(const int nloc, const IdFn& idf, const LdFn& ldf, const EpFn& epf, LAS unsigned char* lds) {
    using pg8::HTB; using pg8::lds_byte; using pg8::stage_rc;
    const int tid = tid_opaque(), lane = tid & 63, wid = __builtin_amdgcn_readfirstlane(tid >> 6), wm = wid >> 2, wn = wid & 3, fr = lane & 15, fq = lane >> 4;
    if (nloc <= 0) return;
    const int total = nloc * NKT;
    int sR[2], sC[2];
#pragma unroll
    for (int i = 0; i < 2; ++i) stage_rc(tid * 16 + i * 8192, sR[i], sC[i]);
    const unsigned ldsw = (unsigned)wid * 1024u;
    const int aoff = lds_byte(wm * 64 + fr, fq * 8), boff = lds_byte(wn * 32 + fr, fq * 8);
#define TS_STAGE(j_) do { const int _j = (j_), _t = _j / NKT, _kt = _j - _t * NKT, _s = _j & 3; const int _id = idf(_t); _Pragma("unroll") for (int _i = 0; _i < 2; ++_i) { \
        const bf16_t* _pa; const bf16_t* _pb; ldf(_id, sR[_i], _kt * 64 + sC[_i], _pa, _pb); \
        __builtin_amdgcn_global_load_lds((const unsigned*)_pa, (LAS unsigned*)(lds + _s * 2 * HTB + ldsw + _i * 8192), 16, 0, 0); \
        __builtin_amdgcn_global_load_lds((const unsigned*)_pb, (LAS unsigned*)(lds + _s * 2 * HTB + HTB + ldsw + _i * 8192), 16, 0, 0); } } while (0)
    TS_STAGE(0);
    if (total > 1) TS_STAGE(1);
    if (total > 2) TS_STAGE(2);
    f32x4 acc[4][2]; zero_acc(acc);
    int kt = 0, tl = 0;
#pragma unroll 1
    for (int j = 0; j < total; ++j) {
        const int ahead = total - 1 - j;
        if (ahead >= 2) asm volatile("s_waitcnt vmcnt(8)" ::: "memory");
        else if (ahead == 1) asm volatile("s_waitcnt vmcnt(4)" ::: "memory");
        else asm volatile("s_waitcnt vmcnt(0)" ::: "memory");
        __builtin_amdgcn_s_barrier();
        asm volatile("" ::: "memory");
        if (j + 3 < total) TS_STAGE(j + 3);
        const LAS unsigned char* Ab = lds + (j & 3) * 2 * HTB; const LAS unsigned char* Bb = Ab + HTB;
#pragma unroll
        for (int ks = 0; ks < 2; ++ks) {
            bf16x8 af[4], bfr[2];
#pragma unroll
            for (int mt = 0; mt < 4; ++mt) af[mt] = *(const LAS bf16x8*)(Ab + aoff + mt * 2048 + ks * 1024);
#pragma unroll
            for (int nt = 0; nt < 2; ++nt) bfr[nt] = *(const LAS bf16x8*)(Bb + boff + nt * 2048 + ks * 1024);
#pragma unroll
            for (int mt = 0; mt < 4; ++mt)
#pragma unroll
                for (int nt = 0; nt < 2; ++nt) acc[mt][nt] = __builtin_amdgcn_mfma_f32_16x16x32_bf16(bfr[nt], af[mt], acc[mt][nt], 0, 0, 0);
        }
        if (++kt == NKT) { epf(idf(tl), acc, wm, wn, lane); zero_acc(acc); kt = 0; ++tl; }
    }
    asm volatile("s_waitcnt lgkmcnt(0)" ::: "memory");
    __builtin_amdgcn_s_barrier();
    asm volatile("" ::: "memory");
#undef TS_STAGE
}

__device__ __forceinline__ void phase_modv(const Ctx& p, LAS unsigned char* lds) {
    LAS float* sl = (LAS float*)lds;
    LAS float* part = sl + 3 * 1024;
    const int tid = threadIdx.x;
    for (int i = tid; i < 3 * 1024; i += NT) {
        const int mi = i >> 10, k = i & 1023;
        const float v = mi < 2 ? p.in(I_C)[mi * 1024 + k] : p.in(I_CCTX)[k];
        sl[i] = silu_f(v);
    }
    __syncthreads();
    float* modv = (float*)(p.ws() + OFF_MODV);
    for (int u = blockIdx.x; u < 4 * 96; u += gridDim.x) {
        const int l = u / 96, cb = u % 96, col = cb * 64 + (tid & 63), kp = tid >> 6;
        const float* w = p.in(I_WMOD) + (size_t)l * 1024 * 6144 + col;
        float a0 = 0.f, a1 = 0.f, a2 = 0.f;
#pragma unroll 32
        for (int k = kp * 128; k < kp * 128 + 128; ++k) {
            const float wv = w[(size_t)k * 6144];
            a0 += sl[k] * wv; a1 += sl[1024 + k] * wv; a2 += sl[2048 + k] * wv;
        }
        part[(kp * 3 + 0) * 64 + (tid & 63)] = a0; part[(kp * 3 + 1) * 64 + (tid & 63)] = a1; part[(kp * 3 + 2) * 64 + (tid & 63)] = a2;
        __syncthreads();
        if (tid < 192) {
            const int mi = tid >> 6, c = tid & 63;
            float s = p.in(I_BMOD)[l * 6144 + cb * 64 + c];
#pragma unroll
            for (int q = 0; q < 8; ++q) s += part[(q * 3 + mi) * 64 + c];
            modv[((size_t)l * 3 + mi) * 6144 + cb * 64 + c] = s;
        }
        __syncthreads();
    }
    if (blockIdx.x == gridDim.x - 1) {
        float* rope = (float*)(p.ws() + OFF_ROPE);
        for (int i = tid; i < 320 * 32; i += NT) {
            const int pos = i >> 5, j = i & 31;
            const float fr = powf(10000.f, -(float)j / 32.f);
            const float posf = pos < 256 ? (float)pos : (float)(pos - 256);
            float s, c; sincosf(posf * fr, &s, &c);
            if (pos < 256) { rope[pos * 32 + j] = c; rope[8192 + pos * 32 + j] = s; }
            else { rope[16384 + (pos - 256) * 32 + j] = c; rope[16384 + 2048 + (pos - 256) * 32 + j] = s; }
        }
    }
}

template <class F>
__device__ __forceinline__ void transpose_unit(bf16_t* __restrict__ dst, const float* __restrict__ src, int ldsrc, int K, int n0, int k0, F srccol) {
    const int tid_ = tid_opaque(), n = n0 + (tid_ & 63), kb = tid_ >> 6, sc = srccol(n);
#pragma unroll
    for (int kk = 0; kk < 8; ++kk) {
        const int k = k0 + kb * 64 + kk * 8;
        float v[8];
#pragma unroll
        for (int i = 0; i < 8; ++i) v[i] = src[(size_t)(k + i) * ldsrc + sc];
        uint4 o; o.x = pack_bf16(v[0], v[1]); o.y = pack_bf16(v[2], v[3]); o.z = pack_bf16(v[4], v[5]); o.w = pack_bf16(v[6], v[7]);
        *(uint4*)(dst + (size_t)n * K + k) = o;
    }
}
__device__ __forceinline__ int rope_perm(int n) {
    const int wn = n >> 5, half = (n >> 4) & 1, i = n & 15;
    return (wn >> 1) * 64 + half * 32 + (wn & 1) * 16 + i;
}
__device__ __forceinline__ void convert_unit(bf16_t* __restrict__ dst, const float* __restrict__ src, size_t e0) {
#pragma unroll
    for (int it = 0; it < 8; ++it) {
        const size_t e = e0 + (size_t)(it * NT + tid_opaque()) * 8;
        const float4 a = *(const float4*)(src + e), b = *(const float4*)(src + e + 4);
        uint4 o; o.x = pack_bf16(a.x, a.y); o.y = pack_bf16(a.z, a.w); o.z = pack_bf16(b.x, b.y); o.w = pack_bf16(b.z, b.w);
        *(uint4*)(dst + e) = o;
    }
}
__device__ __forceinline__ void s5_prep_group(const Ctx& p, int l, int g, int q4, LAS unsigned char* lds);
__device__ __forceinline__ void fp8_rows_unit(unsigned char* __restrict__ dst, float* __restrict__ sinv, const float* __restrict__ src, int row0) {
    const int tid = tid_opaque(), lane = tid & 63, wid = tid >> 6;
#pragma unroll
    for (int rr = 0; rr < 4; ++rr) {
        const int row = row0 + wid * 4 + rr;
        const float* sp = src + (size_t)row * D + lane * 16;
        float4 v[4]; float amax = 0.f;
#pragma unroll
        for (int i = 0; i < 4; ++i) { v[i] = *(const float4*)(sp + i * 4); amax = fmaxf(amax, fmaxf(fmaxf(fabsf(v[i].x), fabsf(v[i].y)), fmaxf(fabsf(v[i].z), fabsf(v[i].w)))); }
#pragma unroll
        for (int o = 32; o > 0; o >>= 1) amax = fmaxf(amax, __shfl_xor(amax, o));
        int e = (int)((__float_as_uint(amax) >> 23) & 0xFFu) - 127;
        e = e < -100 ? -100 : (e > 100 ? 100 : e);
        const float sc = __uint_as_float((unsigned)(127 + 7 - e) << 23), inv = __uint_as_float((unsigned)(127 - 7 + e) << 23);
        u32x4 o4;
#pragma unroll
        for (int i = 0; i < 4; ++i) {
            int w = __builtin_amdgcn_cvt_pk_fp8_f32(v[i].x * sc, v[i].y * sc, 0, false);
            w = __builtin_amdgcn_cvt_pk_fp8_f32(v[i].z * sc, v[i].w * sc, w, true);
            o4[i] = (unsigned)w;
        }
        *(u32x4*)(dst + (size_t)row * D + lane * 16) = o4;
        if (lane == 0) sinv[row] = inv;
    }
}
__device__ __forceinline__ void phase_prep(const Ctx& p, int l, int rot, LAS unsigned char* lds) {
    constexpr int U_S5 = 128, U_WIN = 144, U_GLU = 32, U_RU = 16, U_OUT = 32, U_WQ = 32, U_PU = 512, U_PV = 512, U_SK = 4;
    constexpr int B_WIN = U_S5, B_GLU = B_WIN + U_WIN, B_RU = B_GLU + U_GLU, B_OUT = B_RU + U_RU, B_WQ = B_OUT + U_OUT, B_PU = B_WQ + U_WQ,
                  B_PV = B_PU + U_PU, B_SK = B_PV + U_PV, NU = B_SK + U_SK;
    for (int u = (blockIdx.x + rot) % gridDim.x; u < NU; u += gridDim.x) {
        if (u < B_WIN) {
            s5_prep_group(p, l, u >> 2, u & 3, lds);
        } else if (u < B_GLU) {
            const int v = u - B_WIN;
            transpose_unit((bf16_t*)(wsw(p, l) + OFF_WINT), p.in(I_WIN) + (size_t)l * D * INC, INC, D, (v >> 1) * 64, (v & 1) * 512,
                           [](int n) { return (n >= 512 && n < 1536) ? 512 + ((n - 512) >> 7) * 128 + rope_perm((n - 512) & 127) : n; });
        } else if (u < B_RU) {
            const int v = u - B_GLU;
            transpose_unit((bf16_t*)(wsw(p, l) + OFF_WGLUT), p.in(I_WGLU) + (size_t)l * 512 * 2048, 2048, 512, v * 64, 0,
                           [](int n) { const int ntile = n >> 7, q = n & 127; return ((q >> 4) & 1) * 1024 + ntile * 64 + (q >> 5) * 16 + (q & 15); });
        } else if (u < B_OUT) {
            const int v = u - B_RU;
            transpose_unit((bf16_t*)(wsw(p, l) + OFF_WRUT), p.in(I_WRU) + (size_t)l * 512 * 1024, 1024, 512, v * 64, 0, [](int n) { return n; });
        } else if (u < B_WQ) {
            const int v = u - B_OUT;
            transpose_unit((bf16_t*)(wsw(p, l) + OFF_WOUTT), p.in(I_WOUT) + (size_t)l * D * D, D, D, (v >> 1) * 64, (v & 1) * 512, [](int n) { return n; });
        } else if (u < B_PU) {
            const int v = u - B_WQ;
            transpose_unit((bf16_t*)(wsw(p, l) + OFF_WQT), p.in(I_WQ) + (size_t)l * D * D, D, D, (v >> 1) * 64, (v & 1) * 512, [](int n) { return n; });
        } else if (u < B_PV) {
            fp8_rows_unit(wsw(p, l) + OFF_PU, (float*)(wsw(p, l) + OFF_SCU), p.in(I_PU) + (size_t)l * NEXP * D, (u - B_PU) * 32);
        } else if (u < B_SK) {
            fp8_rows_unit(wsw(p, l) + OFF_PV, (float*)(wsw(p, l) + OFF_SCV), p.in(I_PV) + (size_t)l * NEXP * D, (u - B_PV) * 32);
        } else {
            convert_unit((bf16_t*)(wsw(p, l) + OFF_SKEY), p.in(I_SKEY) + (size_t)l * 16 * 128 * 64, (size_t)(u - B_SK) * 32768);
        }
    }
}

__device__ __forceinline__ const float* x_row_ptr(const Ctx& p, int l, int which, int row) {
    if (row < ML) return (l == 0 && which == 0) ? p.in(I_X) + (size_t)row * D : p.out() + (size_t)row * D;
    return (l == 0 && which == 0) ? p.in(I_CTX) + (size_t)(row - ML) * D : (const float*)(p.ws() + OFF_XC) + (size_t)(row - ML) * D;
}
__device__ __forceinline__ void phase_norm(const Ctx& p, int l, int which) {
    const int tid = tid_opaque(), lane = tid & 63, wid = __builtin_amdgcn_readfirstlane(tid >> 6);
    const float* gain = p.in(which == 0 ? I_N1G : I_N2G) + l * D;
    const float* modv = (const float*)(p.ws() + OFF_MODV) + (size_t)l * 3 * 6144;
    bf16_t* H = (bf16_t*)(p.ws() + OFF_H);
    const int nw = gridDim.x * 8, gw = blockIdx.x * 8 + wid;
    const int mrows = (which == 1 && l == DEPTH - 1) ? ML : M;
#pragma unroll 1
    for (int row0 = gw; row0 < mrows; row0 += 2 * nw) {
        const int row1 = row0 + nw; const bool has1 = row1 < mrows;
        const float* xr0 = x_row_ptr(p, l, which, row0); const float* xr1 = x_row_ptr(p, l, which, has1 ? row1 : row0);
        const float* mv0 = modv + (size_t)mod_index(row0) * 6144 + which * 3072; const float* mv1 = modv + (size_t)mod_index(has1 ? row1 : row0) * 6144 + which * 3072;
        float4 v0[4], v1[4], g[4], sh0[4], sc0[4], sh1[4], sc1[4];
#pragma unroll
        for (int i = 0; i < 4; ++i) {
            const int c = i * 256 + lane * 4;
            v0[i] = *(const float4*)(xr0 + c); v1[i] = *(const float4*)(xr1 + c); g[i] = *(const float4*)(gain + c);
            sh0[i] = *(const float4*)(mv0 + c); sc0[i] = *(const float4*)(mv0 + 1024 + c); sh1[i] = *(const float4*)(mv1 + c); sc1[i] = *(const float4*)(mv1 + 1024 + c);
        }
        float ss0 = 0.f, ss1 = 0.f;
#pragma unroll
        for (int i = 0; i < 4; ++i) {
            ss0 += v0[i].x * v0[i].x + v0[i].y * v0[i].y + v0[i].z * v0[i].z + v0[i].w * v0[i].w;
            ss1 += v1[i].x * v1[i].x + v1[i].y * v1[i].y + v1[i].z * v1[i].z + v1[i].w * v1[i].w;
        }
        ss0 = wave_sum(ss0); ss1 = wave_sum(ss1);
        const float r0 = rsqrtf(ss0 * (1.f / 1024.f) + EPS), r1 = rsqrtf(ss1 * (1.f / 1024.f) + EPS);
#pragma unroll
        for (int i = 0; i < 4; ++i) {
            const int c = i * 256 + lane * 4;
            uint2 o; o.x = pack_bf16(v0[i].x * r0 * g[i].x * (1.f + sc0[i].x) + sh0[i].x, v0[i].y * r0 * g[i].y * (1.f + sc0[i].y) + sh0[i].y);
            o.y = pack_bf16(v0[i].z * r0 * g[i].z * (1.f + sc0[i].z) + sh0[i].z, v0[i].w * r0 * g[i].w * (1.f + sc0[i].w) + sh0[i].w);
            *(uint2*)(H + (size_t)row0 * D + c) = o;
        }
        if (has1) {
#pragma unroll
            for (int i = 0; i < 4; ++i) {
                const int c = i * 256 + lane * 4;
                uint2 o; o.x = pack_bf16(v1[i].x * r1 * g[i].x * (1.f + sc1[i].x) + sh1[i].x, v1[i].y * r1 * g[i].y * (1.f + sc1[i].y) + sh1[i].y);
                o.y = pack_bf16(v1[i].z * r1 * g[i].z * (1.f + sc1[i].z) + sh1[i].z, v1[i].w * r1 * g[i].w * (1.f + sc1[i].w) + sh1[i].w);
                *(uint2*)(H + (size_t)row1 * D + c) = o;
            }
        }
    }
}

struct RowInfo { int b, ts, t; bool lat; };
__device__ __forceinline__ RowInfo row_info(int row) {
    RowInfo r;
    if (row < ML) { r.b = row >> 14; r.t = row & 16383; r.ts = r.t; r.lat = true; }
    else { const int rc = row - ML; r.b = rc >> 8; r.t = rc & 255; r.ts = SEQ + r.t; r.lat = false; }
    return r;
}
__device__ __forceinline__ void store_bf16x4(bf16_t* dst, float a, float b, float c, float d) {
    uint2 o; o.x = pack_bf16(a, b); o.y = pack_bf16(c, d); *(uint2*)dst = o;
}
__device__ __forceinline__ unsigned short f2bf(float f) { return (unsigned short)(pack_bf16(f, 0.f) & 0xFFFFu); }
__device__ __forceinline__ int s5_rowbase(int R) {
    const int b = R / 520, cs = R - b * 520;
    return cs < 512 ? b * SEQ + cs * 32 : ML + b * CTX + (cs - 512) * 32;
}

__device__ __forceinline__ int s5_chunkrow(int row) {
    return row < ML ? (row >> 14) * 520 + ((row & 16383) >> 5) : ((row - ML) >> 8) * 520 + 512 + (((row - ML) & 255) >> 5);
}

__device__ __forceinline__ void s5_prep_group(const Ctx& p, int l, int g, int q4, LAS unsigned char* lds) {
    LAS float* powf = (LAS float*)lds;
    LAS float* powb = powf + 4224;
    LAS float* Gf = powb + 4224;
    LAS float* Gb = Gf + 2048;
    LAS float* Cc = Gb + 2048;
    LAS float* Kt = Cc + 2048;
    const int tid = tid_opaque();
    const int lg = l * 32 + g;
    for (int e = tid; e < 2 * 33 * 64; e += NT) {
        const int dir = e / (33 * 64), k = (e / 64) % 33, pp = e & 63;
        const float lre = p.in(dir ? I_LREB : I_LREF)[lg * 64 + pp], lim = p.in(dir ? I_LIMB : I_LIMF)[lg * 64 + pp];
        const float dt = expf(p.in(dir ? I_LDTB : I_LDTF)[lg]);
        const float mag = expf((float)k * lre * dt);
        float sn, cs; sincosf((float)k * lim * dt, &sn, &cs);
        LAS float* pw = dir ? powb : powf;
        pw[(k * 64 + pp) * 2] = mag * cs; pw[(k * 64 + pp) * 2 + 1] = mag * sn;
    }
    for (int e = tid; e < 2 * 64 * 16; e += NT) {
        const int dir = e >> 10, pp = (e >> 4) & 63, j = e & 15;
        const float lre = p.in(dir ? I_LREB : I_LREF)[lg * 64 + pp], lim = p.in(dir ? I_LIMB : I_LIMF)[lg * 64 + pp];
        const float dt = expf(p.in(dir ? I_LDTB : I_LDTF)[lg]);
        const float mag = expf(lre * dt);
        float sn, cs; sincosf(lim * dt, &sn, &cs);
        const float nr = mag * cs - 1.f, ni = mag * sn, den = lre * lre + lim * lim;
        const float br = (nr * lre + ni * lim) / den, bi = (ni * lre - nr * lim) / den;
        const float Br = p.in(I_BRE)[(lg * 64 + pp) * 16 + j], Bi = p.in(I_BIM)[(lg * 64 + pp) * 16 + j];
        LAS float* G = dir ? Gb : Gf;
        G[(pp * 16 + j) * 2] = br * Br - bi * Bi; G[(pp * 16 + j) * 2 + 1] = br * Bi + bi * Br;
    }
    for (int e = tid; e < 16 * 64; e += NT) {
        Cc[e * 2] = p.in(I_CRE)[lg * 1024 + e]; Cc[e * 2 + 1] = p.in(I_CIM)[lg * 1024 + e];
    }
    __syncthreads();
    for (int e0 = tid; e0 < 63 * 64; e0 += NT) {
        const int idx = e0 >> 6, i = 4 * q4 + ((e0 >> 4) & 3), j = e0 & 15, e = (idx * 16 + i) * 16 + j;
        float acc = 0.f;
        if (idx >= 31) {
            const int lag = idx - 31;
            for (int pp = 0; pp < 64; ++pp) {
                const float cr = Cc[(i * 64 + pp) * 2], ci = Cc[(i * 64 + pp) * 2 + 1], ar = powf[(lag * 64 + pp) * 2], ai = powf[(lag * 64 + pp) * 2 + 1];
                const float zr = cr * ar - ci * ai, zi = cr * ai + ci * ar;
                acc += zr * Gf[(pp * 16 + j) * 2] - zi * Gf[(pp * 16 + j) * 2 + 1];
            }
        }
        if (idx <= 31) {
            const int lag = 31 - idx;
            for (int pp = 0; pp < 64; ++pp) {
                const float cr = Cc[(i * 64 + pp) * 2], ci = Cc[(i * 64 + pp) * 2 + 1], ar = powb[(lag * 64 + pp) * 2], ai = powb[(lag * 64 + pp) * 2 + 1];
                const float zr = cr * ar - ci * ai, zi = cr * ai + ci * ar;
                acc += zr * Gb[(pp * 16 + j) * 2] - zi * Gb[(pp * 16 + j) * 2 + 1];
            }
        }
        if (idx == 31 && i == j) acc += p.in(I_SSMD)[l * 512 + g * 16 + i];
        Kt[e] = acc;
    }
    __syncthreads();
    bf16_t* TV = (bf16_t*)(wsw(p, l) + OFF_S5TV) + (size_t)g * 512 * 768;
    for (int piece = tid; piece < 128 * 96; piece += NT) {
        const int nq = piece / 96, k0 = (piece - nq * 96) * 8, t = nq >> 2, i = 4 * q4 + (nq & 3), n = t * 16 + i;
        float v[8];
        if (k0 < 512) {
            const int s_ = k0 >> 4, j0 = k0 & 15;
#pragma unroll
            for (int q = 0; q < 8; ++q) v[q] = Kt[((31 + t - s_) * 16 + i) * 16 + j0 + q];
        } else {
            const int kk = k0 - 512, comp = kk >> 6, p0 = kk & 63, dir = comp >> 1;
            const LAS float* pw = dir ? powb + (32 - t) * 128 : powf + (t + 1) * 128;
#pragma unroll
            for (int q = 0; q < 8; ++q) {
                const int pp = p0 + q;
                const float cr = Cc[(i * 64 + pp) * 2], ci = Cc[(i * 64 + pp) * 2 + 1], ar = pw[pp * 2], ai = pw[pp * 2 + 1];
                v[q] = (comp & 1) ? -(cr * ai + ci * ar) : (cr * ar - ci * ai);
            }
        }
        uint4 o; o.x = pack_bf16(v[0], v[1]); o.y = pack_bf16(v[2], v[3]); o.z = pack_bf16(v[4], v[5]); o.w = pack_bf16(v[6], v[7]);
        *(uint4*)(TV + (size_t)n * 768 + k0) = o;
    }
    bf16_t* W = (bf16_t*)(wsw(p, l) + OFF_S5W) + (size_t)g * 256 * 512;
    for (int piece = tid; piece < 64 * 64; piece += NT) {
        const int n = 64 * q4 + (piece >> 6), k0 = (piece & 63) * 8, comp = n >> 6, pp = n & 63, s_ = k0 >> 4, j0 = k0 & 15, dir = comp >> 1;
        const LAS float* pw = dir ? powb + (s_ * 64 + pp) * 2 : powf + ((31 - s_) * 64 + pp) * 2;
        const LAS float* G = (dir ? Gb : Gf) + (pp * 16 + j0) * 2;
        const float ar = pw[0], ai = pw[1];
        float v[8];
#pragma unroll
        for (int q = 0; q < 8; ++q) { const float gr = G[q * 2], gi = G[q * 2 + 1]; v[q] = (comp & 1) ? (ar * gi + ai * gr) : (ar * gr - ai * gi); }
        uint4 o; o.x = pack_bf16(v[0], v[1]); o.y = pack_bf16(v[2], v[3]); o.z = pack_bf16(v[4], v[5]); o.w = pack_bf16(v[6], v[7]);
        *(uint4*)(W + (size_t)n * 512 + k0) = o;
    }
    if (tid < 128 && q4 == 0) {
        const int dir = tid >> 6, pp = tid & 63;
        float* AT = (float*)(wsw(p, l) + OFF_S5AT) + ((g * 2 + dir) * 64 + pp) * 2;
        const LAS float* pw = (dir ? powb : powf) + (32 * 64 + pp) * 2;
        AT[0] = pw[0]; AT[1] = pw[1];
    }
    __syncthreads();
}

template <bool SW, class Epi>
__device__ __forceinline__ void thin_ctx_gemm(const bf16_t* A, const bf16_t* Bt, const int K, const int nt_lo, const int nt_hi, const Epi& E, LAS unsigned char* lds) {
    static_assert(SW, "swapped accumulator layout only");
    const int tid = tid_opaque(), lane = tid & 63, wid = __builtin_amdgcn_readfirstlane(tid >> 6), wm = wid >> 2, wn = wid & 3;
    const int ntile = 4 * (nt_hi - nt_lo);
#pragma unroll 1
    for (int t = blockIdx.x; t < ntile; t += gridDim.x) {
        const int mt = t & 3, nt = nt_lo + (t >> 2);
        const bf16_t* Ab = A + (size_t)(ML + mt * 128) * K; const bf16_t* Bb = Bt + (size_t)nt * 128 * K;
        f32x4 acc[4][2]; zero_acc(acc);
        mma_tile_dma(acc, [=](int r, int k) { return Ab + (size_t)r * K + k; }, [=](int r, int k) { return Bb + (size_t)r * K + k; }, K, lds);
        typename Epi::Pre pre;
        E.template prefetch<4>(pre, ML + mt * 128 + wm * 64, nt, wn, lane);
        E.template apply<4>(acc, pre, ML + mt * 128 + wm * 64, nt, wn, lane);
    }
}

struct EpiG1 {
    const Ctx& p; int l;
    template <int NA>
    __device__ __forceinline__ void operator()(const f32x4 (&acc)[NA][2], int rowbase, int nt, int wn, int lane_) const {
        int lane = lane_; asm volatile("" : "+v"(lane));
        const float* rope = (const float*)(p.ws() + OFF_ROPE);
        const int fq = lane >> 4;
        if (nt < 8 || nt >= 16) {
            bf16_t* dst; int ld, c0; bool isq = false;
            if (nt < 4) { dst = (bf16_t*)(p.ws() + OFF_U); ld = 512; c0 = nt * 128; }
            else if (nt < 8) { dst = (bf16_t*)(p.ws() + OFF_Q); ld = 512; c0 = (nt - 4) * 128; isq = true; }
            else if (nt < 20) { dst = (bf16_t*)(p.ws() + OFF_G); ld = 512; c0 = (nt - 16) * 128; }
            else if (nt < 28) { dst = (bf16_t*)(p.ws() + OFF_GS); ld = 1024; c0 = (nt - 20) * 128; }
            else { dst = (bf16_t*)(p.ws() + OFF_GR); ld = 1024; c0 = (nt - 28) * 128; }
            f32x4 rc[NA], rs[NA];
            if (isq) {
#pragma unroll
                for (int a = 0; a < NA; ++a) {
                    const int row = rowbase + a * 16 + (lane & 15);
                    const int t = row & 16383, sec = wn >> 1, pos = (row < ML) ? (sec ? (t & 63) : (t >> 6)) : 0;
                    const float* cs = rope + (sec ? 16384 : 0) + pos * 32 + (wn & 1) * 16 + 4 * fq;
                    rc[a] = *(const f32x4*)cs; rs[a] = *(const f32x4*)(cs + (sec ? 2048 : 8192));
                }
            }
#pragma unroll
            for (int a = 0; a < NA; ++a) {
                const int row = rowbase + a * 16 + (lane & 15);
                f32x4 v0 = acc[a][0], v1 = acc[a][1];
                if (isq && row < ML) {
#pragma unroll
                    for (int r = 0; r < 4; ++r) { const float c = rc[a][r], s_ = rs[a][r], t1 = v0[r], t2 = v1[r]; v0[r] = t1 * c - t2 * s_; v1[r] = t1 * s_ + t2 * c; }
                }
                {
                    bf16_t* rp = nt < 4 ? (bf16_t*)(p.ws() + OFF_AS5) + ((size_t)(nt * 8 + wn * 2) * 1040 + s5_chunkrow(row)) * 768 + (row & 31) * 16 + 4 * fq
                                        : dst + ((size_t)((c0 >> 4) + wn * 2) * M + row) * 16 + 4 * fq;
                    const size_t gstep = nt < 4 ? (size_t)1040 * 768 : (size_t)M * 16;
                    store_bf16x4(rp, v0[0], v0[1], v0[2], v0[3]);
                    store_bf16x4(rp + gstep, v1[0], v1[1], v1[2], v1[3]);
                }
            }
        } else if (nt < 12) {
            const int h = nt - 8;
            const float lgf = -expf(p.in(I_RDF)[l * 4 + h]), lgb = -expf(p.in(I_RDB)[l * 4 + h]);
            bf16_t* Kd = (bf16_t*)(p.ws() + OFF_K); bf16_t* KTF = (bf16_t*)(p.ws() + OFF_KTF); bf16_t* KTB = (bf16_t*)(p.ws() + OFF_KTB);
            const int sec = wn >> 1;
            f32x4 rc[NA], rs[NA];
#pragma unroll
            for (int a = 0; a < NA; ++a) {
                const RowInfo ri = row_info(rowbase + a * 16 + (lane & 15));
                const int pos = ri.lat ? (sec ? (ri.t & 63) : (ri.t >> 6)) : 0;
                const float* cs = rope + (sec ? 16384 : 0) + pos * 32 + (wn & 1) * 16 + 4 * fq;
                rc[a] = *(const f32x4*)cs; rs[a] = *(const f32x4*)(cs + (sec ? 2048 : 8192));
            }
#pragma unroll
            for (int a = 0; a < NA; ++a) {
                const int row = rowbase + a * 16 + (lane & 15);
                const RowInfo ri = row_info(row);
                f32x4 v0 = acc[a][0], v1 = acc[a][1];
                if (ri.lat) {
#pragma unroll
                    for (int r = 0; r < 4; ++r) { const float c = rc[a][r], s_ = rs[a][r], t1 = v0[r], t2 = v1[r]; v0[r] = t1 * c - t2 * s_; v1[r] = t1 * s_ + t2 * c; }
                }
                v0 *= 0.08838834764831845f; v1 *= 0.08838834764831845f;
                bf16_t* rp = Kd + ((size_t)(h * 8 + wn * 2) * M + row) * 16 + 4 * fq;
                store_bf16x4(rp, v0[0], v0[1], v0[2], v0[3]);
                store_bf16x4(rp + (size_t)M * 16, v1[0], v1[1], v1[2], v1[3]);
                const int c_ = ri.t & 127;
                const float ff = __expf(lgf * (float)(127 - c_)), fb = __expf(lgb * (float)c_);
                const size_t tb = ((size_t)(ri.b * 4 + h) * 128 + wn * 32 + 4 * fq) * TS + ri.ts;
#pragma unroll
                for (int r = 0; r < 4; ++r) {
                    KTF[tb + (size_t)r * TS] = f2bf(v0[r] * ff); KTF[tb + (size_t)(r + 16) * TS] = f2bf(v1[r] * ff);
                    KTB[tb + (size_t)r * TS] = f2bf(v0[r] * fb); KTB[tb + (size_t)(r + 16) * TS] = f2bf(v1[r] * fb);
                }
            }
        } else {
            const int h = nt - 12;
            bf16_t* VT = (bf16_t*)(p.ws() + OFF_VT);
#pragma unroll
            for (int a = 0; a < NA; ++a) {
                const int row = rowbase + a * 16 + (lane & 15);
                const RowInfo ri = row_info(row);
                const size_t tb = ((size_t)(ri.b * 4 + h) * 128 + wn * 32 + 4 * fq) * TS + ri.ts;
#pragma unroll
                for (int r = 0; r < 4; ++r) { VT[tb + (size_t)r * TS] = f2bf(acc[a][0][r]); VT[tb + (size_t)(r + 16) * TS] = f2bf(acc[a][1][r]); }
            }
        }
    }
    struct Pre {};
    static constexpr bool PAIR = false;
    template <int NA> __device__ __forceinline__ void prefetch(Pre&, int, int, int, int) const {}
    template <int NA> __device__ __forceinline__ void apply(const f32x4 (&acc)[NA][2], const Pre&, int rowbase, int nt, int wn, int lane) const { this->template operator()<NA>(acc, rowbase, nt, wn, lane); }
};
__device__ __forceinline__ void phase_g1(const Ctx& p, int l, LAS unsigned char* lds) {
    const bf16_t* A = (const bf16_t*)(p.ws() + OFF_H); const bf16_t* Bt = (const bf16_t*)(wsw(p, l) + OFF_WINT);
    pg8::Gemm g{A, Bt, ML, INC, D};
    pg8::StaticOrder S; S.init(ML, INC, (int)gridDim.x, (int)blockIdx.x);
    pg8::gemm_phase(lds, g, S, EpiG1{p, l});
    thin_ctx_gemm<true>(A, Bt, D, 0, 36, EpiG1{p, l}, lds);
}

__device__ __forceinline__ void phase_x1(const Ctx& p, int l, LAS unsigned char* lds) {
    const bf16_t* AS5 = (const bf16_t*)(p.ws() + OFF_AS5);
    constexpr int N_S5 = 32 * 9 * 2, N_RET = NB * 4 * 2 * 130;
    const int xcl = blockIdx.x & 7, xrk = blockIdx.x >> 3, xnp = gridDim.x >> 3;
    {
        const bf16_t* W = (const bf16_t*)(wsw(p, l) + OFF_S5W);
        float* SB = (float*)(p.ws() + OFF_SBUF);
        const int nloc = (4 * 16 - xrk + xnp - 1) / xnp;
        auto idf = [=](int i) { const int tq = xrk + i * xnp; return (xcl + 8 * (tq / 16)) * 18 + tq % 16; };
        auto ldf = [=](int id, int r, int k, const bf16_t*& pa, const bf16_t*& pb) {
            const int g = id / 18, r_ = id - g * 18, mt = r_ >> 1, nt = r_ & 1;
            int R = mt * 128 + r; R = R < 1040 ? R : 1039;
            pa = AS5 + ((size_t)g * 1040 + R) * 768 + k;
            pb = W + ((size_t)g * 256 + nt * 128 + r) * 512 + k;
        };
        auto epf = [=](int id, const f32x4 (&acc)[4][2], int wm, int wn, int lane) {
            const int g = id / 18, r_ = id - g * 18, mt = r_ >> 1, nt = r_ & 1;
#pragma unroll
            for (int a = 0; a < 4; ++a) {
                const int R = mt * 128 + wm * 64 + a * 16 + (lane & 15);
                if (R < 1040) {
#pragma unroll
                    for (int b2 = 0; b2 < 2; ++b2) *(f32x4*)(SB + ((size_t)g * 1040 + R) * 256 + nt * 128 + wn * 32 + b2 * 16 + 4 * (lane >> 4)) = acc[a][b2];
                }
            }
        };
        tile_stream<8>(nloc, idf, ldf, epf, lds);
        if (xrk < 8) {
            const int tid = tid_opaque(), lane = tid & 63, wid = __builtin_amdgcn_readfirstlane(tid >> 6), fr = lane & 15, fq = lane >> 4;
            const int g = xcl + 8 * (xrk >> 1), nt = xrk & 1;
            const bf16_t* Ap = AS5 + ((size_t)g * 1040 + 1024 + fr) * 768 + fq * 8;
            const bf16_t* Bp = W + ((size_t)g * 256 + nt * 128 + wid * 16 + fr) * 512 + fq * 8;
            f32x4 acc0 = {0.f, 0.f, 0.f, 0.f}, acc1 = {0.f, 0.f, 0.f, 0.f};
#pragma unroll
            for (int h = 0; h < 2; ++h) {
                bf16x8 av[8], bv[8];
#pragma unroll
                for (int j = 0; j < 8; ++j) { av[j] = *(const bf16x8*)(Ap + (h * 8 + j) * 32); bv[j] = *(const bf16x8*)(Bp + (h * 8 + j) * 32); }
#pragma unroll
                for (int j = 0; j < 8; j += 2) {
                    acc0 = __builtin_amdgcn_mfma_f32_16x16x32_bf16(bv[j], av[j], acc0, 0, 0, 0);
                    acc1 = __builtin_amdgcn_mfma_f32_16x16x32_bf16(bv[j + 1], av[j + 1], acc1, 0, 0, 0);
                }
            }
            *(f32x4*)(SB + ((size_t)g * 1040 + 1024 + fr) * 256 + nt * 128 + wid * 16 + 4 * fq) = acc0 + acc1;
        }
    }
    {
        const bf16_t* VT = (const bf16_t*)(p.ws() + OFF_VT); const bf16_t* KTF = (const bf16_t*)(p.ws() + OFF_KTF); const bf16_t* KTB = (const bf16_t*)(p.ws() + OFF_KTB);
        bf16_t* KVo = (bf16_t*)(p.ws() + OFF_KV);
        const int first = (blockIdx.x + 64) % gridDim.x;
        const int nloc = (N_RET - first + (int)gridDim.x - 1) / (int)gridDim.x;
        auto idf = [=](int i) { return first + i * (int)gridDim.x; };
        auto ldf = [=](int q, int r, int k, const bf16_t*& pa, const bf16_t*& pb) {
            const int n = q % 130, dir = (q / 130) & 1, bh = q / 260;
            pa = VT + ((size_t)bh * 128 + r) * TS + n * 128 + k;
            pb = (dir ? KTB : KTF) + ((size_t)bh * 128 + r) * TS + n * 128 + k;
        };
        auto epf = [=](int q, const f32x4 (&acc)[4][2], int wm, int wn, int lane) {
            const int n = q % 130, dir = (q / 130) & 1, bh = q / 260;
            bf16_t* KV = KVo + ((size_t)(bh * 2 + dir) * 130 + n) * 16384;
#pragma unroll
            for (int a = 0; a < 4; ++a)
#pragma unroll
                for (int b2 = 0; b2 < 2; ++b2)
                    store_bf16x4(KV + (wm * 64 + a * 16 + (lane & 15)) * 128 + wn * 32 + b2 * 16 + 4 * (lane >> 4), acc[a][b2][0], acc[a][b2][1], acc[a][b2][2], acc[a][b2][3]);
        };
        tile_stream<2>(nloc, idf, ldf, epf, lds);
    }
}

__device__ __forceinline__ void phase_x2(const Ctx& p, int l, LAS unsigned char* lds) {
    const int tid = tid_opaque();
    {
        const int gid = blockIdx.x * NT + tid;
        if (gid < 16 * 8192) {
            const int seq = gid >> 13, off = (gid & 8191) * 2, dir = seq & 1, h = (seq >> 1) & 3;
            const float lg = -expf(p.in(dir ? I_RDB : I_RDF)[l * 4 + h]);
            const float dec = expf(128.f * lg);
            const bf16_t* KV = (const bf16_t*)(p.ws() + OFF_KV) + (size_t)seq * 130 * 16384 + off;
            bf16_t* SB = (bf16_t*)(p.ws() + OFF_SBEF) + (size_t)seq * 130 * 16384 + off;
            float s0 = 0.f, s1 = 0.f;
#pragma unroll 1
            for (int v0 = 0; v0 < 130; v0 += 26) {
                unsigned kv[26];
#pragma unroll
                for (int j = 0; j < 26; ++j) { const int v = v0 + j, n = dir ? 129 - v : (v < 2 ? 128 + v : v - 2); kv[j] = *(const unsigned*)(KV + (size_t)n * 16384); }
#pragma unroll
                for (int j = 0; j < 26; ++j) {
                    const int v = v0 + j, n = dir ? 129 - v : (v < 2 ? 128 + v : v - 2);
                    *(unsigned*)(SB + (size_t)n * 16384) = pack_bf16(s0, s1);
                    s0 = dec * s0 + __uint_as_float(kv[j] << 16); s1 = dec * s1 + __uint_as_float(kv[j] & 0xFFFF0000u);
                }
            }
        }
    }
    if (blockIdx.x < 128) {
        const int u = blockIdx.x, b = u >> 6, g = (u >> 1) & 31, dir = u & 1;
        LAS float* tot = (LAS float*)lds;
        const float* SBUF = (const float*)(p.ws() + OFF_SBUF) + ((size_t)g * 1040 + b * 520) * 256 + dir * 128;
        bf16_t* HIN = (bf16_t*)(p.ws() + OFF_AS5) + ((size_t)g * 1040 + b * 520) * 768 + 512 + dir * 128;
        const int seg = tid >> 6, pp = tid & 63, v0 = seg * 65;
        const float* AT = (const float*)(wsw(p, l) + OFF_S5AT) + ((g * 2 + dir) * 64 + pp) * 2;
        const float ar = AT[0], ai = AT[1];
        float hr = 0.f, hi = 0.f;
#pragma unroll 13
        for (int i = 0; i < 65; ++i) {
            const int v = v0 + i, cs = dir ? 519 - v : (v < 8 ? 512 + v : v - 8);
            const float sr = SBUF[(size_t)cs * 256 + pp], si = SBUF[(size_t)cs * 256 + 64 + pp];
            const float nr = ar * hr - ai * hi + sr, ni = ar * hi + ai * hr + si;
            hr = nr; hi = ni;
        }
        tot[(seg * 64 + pp) * 2] = hr; tot[(seg * 64 + pp) * 2 + 1] = hi;
        float br = 1.f, bi = 0.f;
        for (int i = 0; i < 65; ++i) { const float nr = br * ar - bi * ai, ni = br * ai + bi * ar; br = nr; bi = ni; }
        __syncthreads();
        hr = 0.f; hi = 0.f;
        for (int s2 = 0; s2 < seg; ++s2) {
            const float tr = tot[(s2 * 64 + pp) * 2], ti = tot[(s2 * 64 + pp) * 2 + 1];
            const float nr = br * hr - bi * hi + tr, ni = br * hi + bi * hr + ti;
            hr = nr; hi = ni;
        }
#pragma unroll 1
        for (int i0 = 0; i0 < 65; i0 += 13) {
            float sr[13], si[13];
#pragma unroll
            for (int j = 0; j < 13; ++j) { const int v = v0 + i0 + j, cs = dir ? 519 - v : (v < 8 ? 512 + v : v - 8); sr[j] = SBUF[(size_t)cs * 256 + pp]; si[j] = SBUF[(size_t)cs * 256 + 64 + pp]; }
#pragma unroll
            for (int j = 0; j < 13; ++j) {
                const int v = v0 + i0 + j, cs = dir ? 519 - v : (v < 8 ? 512 + v : v - 8);
                HIN[(size_t)cs * 768 + pp] = f2bf(hr); HIN[(size_t)cs * 768 + 64 + pp] = f2bf(hi);
                const float nr = ar * hr - ai * hi + sr[j], ni = ar * hi + ai * hr + si[j];
                hr = nr; hi = ni;
            }
        }
        __syncthreads();
    }
}

struct S5cOrder {
    int c;
    __device__ __forceinline__ bool next(int i, pg8::Unit& u) const {
        if (i > 0) return false;
        const int xcl = c & 7, xrk = c >> 3, g = xcl + 8 * (xrk >> 3);
        u.pm = g * 4 + ((xrk & 7) >> 1); u.pn = xrk & 1; return true;
    }
    __device__ __forceinline__ const char* abase(const pg8::Gemm& g, const pg8::Unit& u) const { return (const char*)g.A + ((size_t)(u.pm >> 2) * 1040 + (u.pm & 3) * 256) * (768 * 2); }
    __device__ __forceinline__ const char* bbase(const pg8::Gemm& g, const pg8::Unit& u) const { return (const char*)g.Bt + ((size_t)(u.pm >> 2) * 512 + u.pn * 256) * (768 * 2); }
};
struct EpiS5C {
    const Ctx& p;
    struct Pre {};
    static constexpr bool PAIR = false;
    template <int NA> __device__ __forceinline__ void prefetch(Pre&, int, int, int, int) const {}
    template <int NA>
    __device__ __forceinline__ void apply(const f32x4 (&acc)[NA][2], const Pre&, int rowbase, int nt, int wn, int lane_) const {
        int lane = lane_; asm volatile("" : "+v"(lane));
        bf16_t* YS = (bf16_t*)(p.ws() + OFF_YS);
        const int g = rowbase >> 10;
#pragma unroll
        for (int a = 0; a < NA; ++a) {
            const int rb = s5_rowbase((rowbase & 1023) + a * 16 + (lane & 15));
#pragma unroll
            for (int b2 = 0; b2 < 2; ++b2) {
                const int n = nt * 128 + wn * 32 + b2 * 16 + 4 * (lane >> 4), t = n >> 4, i = n & 15;
                store_bf16x4(YS + (size_t)(rb + t) * 512 + g * 16 + i, gelu_tanh_f(acc[a][b2][0]), gelu_tanh_f(acc[a][b2][1]), gelu_tanh_f(acc[a][b2][2]), gelu_tanh_f(acc[a][b2][3]));
            }
        }
    }
};
__device__ __forceinline__ void phase_x3(const Ctx& p, int l, LAS unsigned char* lds) {
    const int tid = tid_opaque(), lane = tid & 63, wid = __builtin_amdgcn_readfirstlane(tid >> 6), wm = wid >> 2, wn = wid & 3;
    constexpr int N_RET = NB * 4 * 130;
    const int xcl = blockIdx.x & 7, xrk = blockIdx.x >> 3;
    {
        pg8::Gemm g{(const bf16_t*)(p.ws() + OFF_AS5), (const bf16_t*)(wsw(p, l) + OFF_S5TV), 32 * 1024, 512, 768};
        S5cOrder S; S.c = (int)blockIdx.x;
        pg8::gemm_phase(lds, g, S, EpiS5C{p});
    }
    if (xrk < 16) {
        const int g = xcl + 8 * (xrk >> 2), nt = xrk & 3, fr = lane & 15, fq = lane >> 4;
        const bf16_t* Ap = (const bf16_t*)(p.ws() + OFF_AS5) + ((size_t)g * 1040 + 1024 + fr) * 768 + fq * 8;
        const bf16_t* Bp = (const bf16_t*)(wsw(p, l) + OFF_S5TV) + ((size_t)g * 512 + nt * 128 + wid * 16 + fr) * 768 + fq * 8;
        f32x4 acc0 = {0.f, 0.f, 0.f, 0.f}, acc1 = {0.f, 0.f, 0.f, 0.f};
#pragma unroll
        for (int h = 0; h < 2; ++h) {
            bf16x8 av[12], bv[12];
#pragma unroll
            for (int j = 0; j < 12; ++j) { av[j] = *(const bf16x8*)(Ap + (h * 12 + j) * 32); bv[j] = *(const bf16x8*)(Bp + (h * 12 + j) * 32); }
#pragma unroll
            for (int j = 0; j < 12; j += 2) {
                acc0 = __builtin_amdgcn_mfma_f32_16x16x32_bf16(bv[j], av[j], acc0, 0, 0, 0);
                acc1 = __builtin_amdgcn_mfma_f32_16x16x32_bf16(bv[j + 1], av[j + 1], acc1, 0, 0, 0);
            }
        }
        const f32x4 acc = acc0 + acc1;
        bf16_t* YS = (bf16_t*)(p.ws() + OFF_YS);
        const int rb = s5_rowbase(1024 + fr), t = nt * 8 + wid;
        store_bf16x4(YS + (size_t)(rb + t) * 512 + g * 16 + 4 * fq, gelu_tanh_f(acc[0]), gelu_tanh_f(acc[1]), gelu_tanh_f(acc[2]), gelu_tanh_f(acc[3]));
    }
    {
        using pg8::HTB; using pg8::lds_byte; using pg8::stage_rc;
        constexpr int QO = 0, S0 = 2 * HTB, S1 = 4 * HTB, PO = 6 * HTB, RED = 8 * HTB;
        const int fr = lane & 15, fq = lane >> 4;
        int sR[2], sC[2];
#pragma unroll
        for (int i = 0; i < 2; ++i) stage_rc(tid * 16 + i * 8192, sR[i], sC[i]);
        const unsigned ldsw = (unsigned)wid * 1024u;
        const int aoff = lds_byte(wm * 64 + fr, fq * 8), boff = lds_byte(wn * 32 + fr, fq * 8);
#define RC_STAGE(off, base, ld) do { _Pragma("unroll") for (int _kh = 0; _kh < 2; ++_kh) { _Pragma("unroll") for (int _i = 0; _i < 2; ++_i) \
            __builtin_amdgcn_global_load_lds((const unsigned*)((base) + (size_t)sR[_i] * (ld) + sC[_i] + 64 * _kh), (LAS unsigned*)(lds + (off) + _kh * HTB + ldsw + _i * 8192), 16, 0, 0); } } while (0)
#define RC_STAGE_G(off, base) do { _Pragma("unroll") for (int _kh = 0; _kh < 2; ++_kh) { _Pragma("unroll") for (int _i = 0; _i < 2; ++_i) \
            __builtin_amdgcn_global_load_lds((const unsigned*)((base) + ((size_t)((sC[_i] + 64 * _kh) >> 4) * M + sR[_i]) * 16 + (sC[_i] & 15)), (LAS unsigned*)(lds + (off) + _kh * HTB + ldsw + _i * 8192), 16, 0, 0); } } while (0)
#define RC_MMA(aimg, bimg) do { _Pragma("unroll") for (int _k = 0; _k < 4; ++_k) { bf16x8 _af[4], _bf[2]; \
            _Pragma("unroll") for (int m = 0; m < 4; ++m) _af[m] = *(const LAS bf16x8*)(lds + (aimg) + (_k >> 1) * HTB + aoff + m * 2048 + (_k & 1) * 1024); \
            _Pragma("unroll") for (int n2 = 0; n2 < 2; ++n2) _bf[n2] = *(const LAS bf16x8*)(lds + (bimg) + (_k >> 1) * HTB + boff + n2 * 2048 + (_k & 1) * 1024); \
            _Pragma("unroll") for (int m = 0; m < 4; ++m) _Pragma("unroll") for (int n2 = 0; n2 < 2; ++n2) \
                acc[m][n2] = __builtin_amdgcn_mfma_f32_16x16x32_bf16(_bf[n2], _af[m], acc[m][n2], 0, 0, 0); } } while (0)
#define RC_WAIT(n) asm volatile("s_waitcnt vmcnt(" #n ")" ::: "memory")
#define RC_BAR() do { asm volatile("s_waitcnt lgkmcnt(0)" ::: "memory"); __builtin_amdgcn_s_barrier(); asm volatile("" ::: "memory"); } while (0)
#pragma unroll 1
        for (int id = (blockIdx.x + gridDim.x / 2) % gridDim.x; id < N_RET; id += gridDim.x) {
            const int n = id % 130, bh = id / 130, h = bh & 3, b = bh >> 2;
            if (l == DEPTH - 1 && n >= 128) continue;
            const int rowbase = n < 128 ? b * SEQ + n * 128 : ML + b * CTX + (n - 128) * 128;
            const float lgf = -expf(p.in(I_RDF)[l * 4 + h]), lgb = -expf(p.in(I_RDB)[l * 4 + h]);
            const bf16_t* Qb = (const bf16_t*)(p.ws() + OFF_Q) + ((size_t)(h * 8) * M + rowbase) * 16;
            const bf16_t* Kb = (const bf16_t*)(p.ws() + OFF_K) + ((size_t)(h * 8) * M + rowbase) * 16;
            const bf16_t* Sf = (const bf16_t*)(p.ws() + OFF_SBEF) + ((size_t)(bh * 2 + 0) * 130 + n) * 16384;
            const bf16_t* Rb = (const bf16_t*)(p.ws() + OFF_SBEF) + ((size_t)(bh * 2 + 1) * 130 + n) * 16384;
            const bf16_t* Vb = (const bf16_t*)(p.ws() + OFF_VT) + (size_t)bh * 128 * TS + n * 128;
            const bf16_t* G = (const bf16_t*)(p.ws() + OFF_G) + ((size_t)(h * 8) * M + rowbase) * 16;
            uint2 gv[4][2];
#pragma unroll
            for (int a = 0; a < 4; ++a)
#pragma unroll
                for (int b2 = 0; b2 < 2; ++b2) gv[a][b2] = *(const uint2*)(G + ((size_t)(wn * 2 + b2) * M + wm * 64 + a * 16 + fr) * 16 + 4 * fq);
            RC_STAGE_G(QO, Qb); RC_STAGE_G(S0, Kb); RC_STAGE(S1, Rb, 128);
            f32x4 acc[4][2]; zero_acc(acc);
            RC_WAIT(4); RC_BAR();
            RC_MMA(QO, S0);
#pragma unroll
            for (int a = 0; a < 4; ++a) {
                const int c = wm * 64 + a * 16 + fr;
#pragma unroll
                for (int b2 = 0; b2 < 2; ++b2) {
                    const int m0 = wn * 32 + b2 * 16 + 4 * fq;
                    float pv[4];
#pragma unroll
                    for (int r = 0; r < 4; ++r) { const int m = m0 + r; pv[r] = acc[a][b2][r] * (c >= m ? __expf(lgf * (float)(c - m)) : __expf(lgb * (float)(m - c))); }
                    u32x2 o; o[0] = pack_bf16(pv[0], pv[1]); o[1] = pack_bf16(pv[2], pv[3]);
                    *(LAS u32x2*)(lds + PO + (m0 >> 6) * HTB + lds_byte(c, m0 & 63)) = o;
                }
            }
            RC_BAR();
            RC_STAGE(S0, Sf, 128);
            zero_acc(acc);
            RC_WAIT(4); RC_BAR();
            RC_MMA(QO, S1);
#pragma unroll
            for (int a = 0; a < 4; ++a) {
                const int c = wm * 64 + a * 16 + fr;
                const float rr = __expf(lgb * (float)(128 - c) - lgf * (float)(c + 1));
#pragma unroll
                for (int b2 = 0; b2 < 2; ++b2)
#pragma unroll
                    for (int r = 0; r < 4; ++r) acc[a][b2][r] *= rr;
            }
            RC_BAR();
            RC_STAGE(S1, Vb, TS);
            RC_WAIT(4); RC_BAR();
            RC_MMA(QO, S0);
#pragma unroll
            for (int a = 0; a < 4; ++a) {
                const int c = wm * 64 + a * 16 + fr;
                const float ff = __expf(lgf * (float)(c + 1));
#pragma unroll
                for (int b2 = 0; b2 < 2; ++b2)
#pragma unroll
                    for (int r = 0; r < 4; ++r) acc[a][b2][r] *= ff;
            }
            RC_WAIT(0); RC_BAR();
            RC_MMA(PO, S1);
            LAS float* red = (LAS float*)(lds + RED);
#pragma unroll
            for (int a = 0; a < 4; ++a) {
                float ss = 0.f;
#pragma unroll
                for (int b2 = 0; b2 < 2; ++b2)
#pragma unroll
                    for (int r = 0; r < 4; ++r) ss += acc[a][b2][r] * acc[a][b2][r];
                ss += __shfl_xor(ss, 16); ss += __shfl_xor(ss, 32);
                if (lane < 16) red[wn * 128 + wm * 64 + a * 16 + lane] = ss;
            }
            RC_BAR();
            bf16_t* YR = (bf16_t*)(p.ws() + OFF_YR);
#pragma unroll
            for (int a = 0; a < 4; ++a) {
                const int c = wm * 64 + a * 16 + fr;
                const float tot = red[c] + red[128 + c] + red[256 + c] + red[384 + c];
                const float rstd = rsqrtf(tot * (1.f / 128.f) + EPS);
#pragma unroll
                for (int b2 = 0; b2 < 2; ++b2) {
                    const int e = wn * 32 + b2 * 16 + 4 * fq;
                    const uint2 g_ = gv[a][b2];
                    const float g0 = __uint_as_float(g_.x << 16), g1 = __uint_as_float(g_.x & 0xFFFF0000u), g2 = __uint_as_float(g_.y << 16), g3 = __uint_as_float(g_.y & 0xFFFF0000u);
                    store_bf16x4(YR + (size_t)(rowbase + c) * 512 + h * 128 + e, acc[a][b2][0] * rstd * silu_f(g0), acc[a][b2][1] * rstd * silu_f(g1),
                                 acc[a][b2][2] * rstd * silu_f(g2), acc[a][b2][3] * rstd * silu_f(g3));
                }
            }
            RC_BAR();
        }
#undef RC_STAGE
#undef RC_STAGE_G
#undef RC_MMA
#undef RC_WAIT
#undef RC_BAR
    }
}

struct EpiG2 {
    const Ctx& p;
    struct Pre { uint2 gs[4]; };
    static constexpr bool PAIR = true;
    template <int NA>
    __device__ __forceinline__ void prefetch(Pre& q, int rowbase, int nt, int wn, int lane) const {
        const bf16_t* GS = (const bf16_t*)(p.ws() + OFF_GS);
#pragma unroll
        for (int a = 0; a < NA; ++a) q.gs[a] = *(const uint2*)(GS + ((size_t)(nt * 4 + wn) * M + rowbase + a * 16 + (lane & 15)) * 16 + 4 * (lane >> 4));
    }
    template <int NA>
    __device__ __forceinline__ void apply(const f32x4 (&acc)[NA][2], const Pre& q, int rowbase, int nt, int wn, int lane) const {
        bf16_t* MP = (bf16_t*)(p.ws() + OFF_H);
#pragma unroll
        for (int a = 0; a < NA; ++a) {
            const int row = rowbase + a * 16 + (lane & 15), j = nt * 64 + wn * 16 + 4 * (lane >> 4);
            const uint2 gv = q.gs[a];
            const float s0 = sigmoid_f(__uint_as_float(gv.x << 16)), s1 = sigmoid_f(__uint_as_float(gv.x & 0xFFFF0000u));
            const float s2 = sigmoid_f(__uint_as_float(gv.y << 16)), s3 = sigmoid_f(__uint_as_float(gv.y & 0xFFFF0000u));
            store_bf16x4(MP + (size_t)row * D + j, acc[a][0][0] * sigmoid_f(acc[a][1][0]) * s0, acc[a][0][1] * sigmoid_f(acc[a][1][1]) * s1,
                         acc[a][0][2] * sigmoid_f(acc[a][1][2]) * s2, acc[a][0][3] * sigmoid_f(acc[a][1][3]) * s3);
        }
    }
};
struct EpiG3 {
    const Ctx& p;
    struct Pre { uint2 gr[4][2], mp[4][2]; };
    static constexpr bool PAIR = true;
    template <int NA>
    __device__ __forceinline__ void prefetch(Pre& q, int rowbase, int nt, int wn, int lane) const {
        const bf16_t* GR = (const bf16_t*)(p.ws() + OFF_GR); const bf16_t* MP = (const bf16_t*)(p.ws() + OFF_H);
#pragma unroll
        for (int a = 0; a < NA; ++a)
#pragma unroll
            for (int b2 = 0; b2 < 2; ++b2) {
                const size_t o = (size_t)(rowbase + a * 16 + (lane & 15)) * D + nt * 128 + wn * 32 + b2 * 16 + 4 * (lane >> 4);
                q.gr[a][b2] = *(const uint2*)(GR + ((size_t)(nt * 8 + wn * 2 + b2) * M + rowbase + a * 16 + (lane & 15)) * 16 + 4 * (lane >> 4));
                q.mp[a][b2] = *(const uint2*)(MP + o);
            }
    }
    template <int NA>
    __device__ __forceinline__ void apply(const f32x4 (&acc)[NA][2], const Pre& q, int rowbase, int nt, int wn, int lane) const {
        bf16_t* MP = (bf16_t*)(p.ws() + OFF_H);
#pragma unroll
        for (int a = 0; a < NA; ++a)
#pragma unroll
            for (int b2 = 0; b2 < 2; ++b2) {
                const int row = rowbase + a * 16 + (lane & 15), col = nt * 128 + wn * 32 + b2 * 16 + 4 * (lane >> 4);
                const uint2 gv = q.gr[a][b2], mv = q.mp[a][b2];
                store_bf16x4(MP + (size_t)row * D + col,
                             __uint_as_float(mv.x << 16) + sigmoid_f(__uint_as_float(gv.x << 16)) * acc[a][b2][0],
                             __uint_as_float(mv.x & 0xFFFF0000u) + sigmoid_f(__uint_as_float(gv.x & 0xFFFF0000u)) * acc[a][b2][1],
                             __uint_as_float(mv.y << 16) + sigmoid_f(__uint_as_float(gv.y << 16)) * acc[a][b2][2],
                             __uint_as_float(mv.y & 0xFFFF0000u) + sigmoid_f(__uint_as_float(gv.y & 0xFFFF0000u)) * acc[a][b2][3]);
            }
    }
};
struct EpiG4 {
    const Ctx& p; int l;
    struct Pre { f32x4 x[4][2]; };
    static constexpr bool PAIR = false;
    template <int NA>
    __device__ __forceinline__ void prefetch(Pre& q, int rowbase, int nt, int wn, int lane) const {
#pragma unroll
        for (int a = 0; a < NA; ++a) {
            const float* xin = x_row_ptr(p, l, 0, rowbase + a * 16 + (lane & 15));
#pragma unroll
            for (int b2 = 0; b2 < 2; ++b2) q.x[a][b2] = *(const f32x4*)(xin + nt * 128 + wn * 32 + b2 * 16 + 4 * (lane >> 4));
        }
    }
    template <int NA>
    __device__ __forceinline__ void apply(const f32x4 (&acc)[NA][2], const Pre& q, int rowbase, int nt, int wn, int lane) const {
        const float* modv = (const float*)(p.ws() + OFF_MODV) + (size_t)l * 3 * 6144;
#pragma unroll
        for (int a = 0; a < NA; ++a) {
            const int row = rowbase + a * 16 + (lane & 15);
            float* xo = row < ML ? p.out() + (size_t)row * D : (float*)(p.ws() + OFF_XC) + (size_t)(row - ML) * D;
            const float* g1 = modv + (size_t)mod_index(row) * 6144 + 2048;
#pragma unroll
            for (int b2 = 0; b2 < 2; ++b2) {
                const int col = nt * 128 + wn * 32 + b2 * 16 + 4 * (lane >> 4);
                const f32x4 gv = *(const f32x4*)(g1 + col);
                *(f32x4*)(xo + col) = q.x[a][b2] + gv * acc[a][b2];
            }
        }
    }
};
__device__ __forceinline__ void phase_g2(const Ctx& p, int l, LAS unsigned char* lds) {
    pg8::Gemm g{(const bf16_t*)(p.ws() + OFF_YS), (const bf16_t*)(wsw(p, l) + OFF_WGLUT), ML, 2048, 512};
    pg8::StaticOrder S; S.init(ML, 2048, (int)gridDim.x, (int)blockIdx.x);
    pg8::gemm_phase(lds, g, S, EpiG2{p});
    if (l < DEPTH - 1) thin_ctx_gemm<true>(g.A, g.Bt, 512, 0, 16, EpiG2{p}, lds);
}
__device__ __forceinline__ void phase_g3(const Ctx& p, int l, LAS unsigned char* lds) {
    pg8::Gemm g{(const bf16_t*)(p.ws() + OFF_YR), (const bf16_t*)(wsw(p, l) + OFF_WRUT), ML, 1024, 512};
    pg8::StaticOrder S; S.init(ML, 1024, (int)gridDim.x, (int)blockIdx.x);
    pg8::gemm_phase(lds, g, S, EpiG3{p});
    if (l < DEPTH - 1) thin_ctx_gemm<true>(g.A, g.Bt, 512, 0, 8, EpiG3{p}, lds);
}
__device__ __forceinline__ void phase_g4(const Ctx& p, int l, LAS unsigned char* lds) {
    pg8::Gemm g{(const bf16_t*)(p.ws() + OFF_H), (const bf16_t*)(wsw(p, l) + OFF_WOUTT), ML, 1024, 1024};
    pg8::StaticOrder S; S.init(ML, 1024, (int)gridDim.x, (int)blockIdx.x);
    pg8::gemm_phase(lds, g, S, EpiG4{p, l});
    if (l < DEPTH - 1) thin_ctx_gemm<true>(g.A, g.Bt, 1024, 0, 8, EpiG4{p, l}, lds);
}

struct EpiG5 {
    const Ctx& p;
    template <int NA>
    __device__ __forceinline__ void operator()(const f32x4 (&acc)[NA][2], int rowbase, int nt, int wn, int lane) const {
        bf16_t* QP = (bf16_t*)(p.ws() + OFF_QP);
#pragma unroll
        for (int a = 0; a < NA; ++a)
#pragma unroll
            for (int b = 0; b < 2; ++b) {
                const int row = rowbase + a * 16 + (lane & 15);
                store_bf16x4(QP + ((size_t)(nt * 8 + wn * 2 + b) * M + row) * 16 + 4 * (lane >> 4), acc[a][b][0], acc[a][b][1], acc[a][b][2], acc[a][b][3]);
            }
    }
    struct Pre {};
    static constexpr bool PAIR = false;
    template <int NA> __device__ __forceinline__ void prefetch(Pre&, int, int, int, int) const {}
    template <int NA> __device__ __forceinline__ void apply(const f32x4 (&acc)[NA][2], const Pre&, int rowbase, int nt, int wn, int lane) const { this->template operator()<NA>(acc, rowbase, nt, wn, lane); }
};
__device__ __forceinline__ void phase_g5(const Ctx& p, int l, LAS unsigned char* lds) {
    pg8::Gemm g{(const bf16_t*)(p.ws() + OFF_H), (const bf16_t*)(wsw(p, l) + OFF_WQT), ML, 1024, 1024};
    pg8::StaticOrder S; S.init(ML, 1024, (int)gridDim.x, (int)blockIdx.x);
    pg8::gemm_phase(lds, g, S, EpiG5{p});
    if (l < DEPTH - 1) thin_ctx_gemm<true>(g.A, g.Bt, 1024, 0, 8, EpiG5{p}, lds);
}

__device__ __forceinline__ unsigned f2ord(float f) { const unsigned b = __float_as_uint(f); return b ^ ((b >> 31) ? 0xFFFFFFFFu : 0x80000000u); }
__device__ __forceinline__ float ord2f(unsigned o) { return __uint_as_float((o >> 31) ? (o & 0x7FFFFFFFu) : ~o); }
#define CE_DESC(a, b) do { const unsigned _x = (a), _y = (b); (a) = _x > _y ? _x : _y; (b) = _x > _y ? _y : _x; } while (0)
struct Net16 { unsigned char a[63], b[63]; };
constexpr Net16 NET16 = {{0,2,4,6,8,10,12,14,0,1,4,5,8,9,12,13,1,5,9,13,0,1,2,3,8,9,10,11,2,3,10,11,1,3,5,9,11,13,0,1,2,3,4,5,6,7,4,5,6,7,2,3,6,7,10,11,1,3,5,7,9,11,13},
                         {1,3,5,7,9,11,13,15,2,3,6,7,10,11,14,15,2,6,10,14,4,5,6,7,12,13,14,15,4,5,12,13,2,4,6,10,12,14,8,9,10,11,12,13,14,15,8,9,10,11,4,5,8,9,12,13,2,4,6,8,10,12,14}};
__device__ __forceinline__ void sort16_desc(unsigned (&v)[16]) {
#pragma unroll
    for (int t = 0; t < 63; ++t) CE_DESC(v[NET16.a[t]], v[NET16.b[t]]);
}
__device__ __forceinline__ void bitonic_merge16_desc(unsigned (&v)[16]) {
#pragma unroll
    for (int j = 8; j > 0; j >>= 1)
#pragma unroll
        for (int i = 0; i < 16; ++i) { const int l = i ^ j; if (l > i) CE_DESC(v[i], v[l]); }
}
__device__ __forceinline__ void merge_top16(unsigned (&x)[16], const unsigned (&y)[16]) {
#pragma unroll
    for (int i = 0; i < 16; ++i) x[i] = x[i] > y[15 - i] ? x[i] : y[15 - i];
    bitonic_merge16_desc(x);
}
struct CandList { int i[64], j[64], n; };
constexpr CandList make_cands() {
    CandList c{}; c.n = 0;
    for (int i = 0; i < 16; ++i) for (int j = 0; j < 16; ++j) if ((i + 1) * (j + 1) <= 16) { c.i[c.n] = i; c.j[c.n] = j; ++c.n; }
    for (int k = c.n; k < 64; ++k) { c.i[k] = -1; c.j[k] = -1; }
    return c;
}
constexpr CandList CANDS = make_cands();
static_assert(CANDS.n == 50, "candidate count");

__device__ __forceinline__ void phase_select(const Ctx& p, int l, LAS unsigned char* lds) {
    const int tid = tid_opaque(), lane = tid & 63, wid = __builtin_amdgcn_readfirstlane(tid >> 6), tok = lane & 15, fq = lane >> 4;
    const bf16_t* QP = (const bf16_t*)(p.ws() + OFF_QP); const bf16_t* SK = (const bf16_t*)(wsw(p, l) + OFF_SKEY);
    int* IDX = (int*)(p.ws() + OFF_IDX); float* GATE = (float*)(p.ws() + OFF_GATE);
    LAS unsigned* myl = (LAS unsigned*)lds + wid * 2048 + lane;
    const int gw = blockIdx.x * 8 + wid, nw = gridDim.x * 8;
    const int NFULL = ((M / 16) / nw) * nw;
    const int nrem = (l == DEPTH - 1) ? 0 : (M / 16 - NFULL) * 4;
    const int nitems = NFULL / nw + (gw < nrem ? 1 : 0) + ((gw + nw) < nrem ? 1 : 0);
#pragma unroll 1
    for (int it = 0; it < nitems; ++it) {
        int task, hp_lo, hp_hi;
        if (it < NFULL / nw) { task = it * nw + gw; hp_lo = 0; hp_hi = 4; }
        else { const int e = gw + (it - NFULL / nw) * nw; task = NFULL + (e >> 2); hp_lo = e & 3; hp_hi = hp_lo + 1; }
        const int r0 = task * 16;
        unsigned LA0[2][16], LB0[2][16];
#pragma unroll
        for (int i = 0; i < 16; ++i) { LA0[0][i] = 0u; LA0[1][i] = 0u; LB0[0][i] = 0u; LB0[1][i] = 0u; }
        const bool use_lds = it < NFULL / nw;
#pragma unroll 1
        for (int hp = hp_lo; hp < hp_hi; ++hp) {
          if (use_lds) {
              __syncthreads();
#pragma unroll 2
              for (int i = 0; i < 8; ++i) {
                  const int pc = i * NT + tid, q = pc >> 10, row = (pc >> 3) & 127, c = (pc & 7) * 8;
                  *(LAS u32x4*)(lds + 65536 + ((q * 128 + row) * 72 + c) * 2) = *(const u32x4*)(SK + (size_t)((hp * 4 + q) * 128 + row) * 64 + c);
              }
              __syncthreads();
          }
#pragma unroll
          for (int hh = 0; hh < 2; ++hh) {
            const int h = hp * 2 + hh;
#pragma unroll
            for (int s = 0; s < 2; ++s) {
                f32x4 acc[8];
#pragma unroll
                for (int n = 0; n < 8; ++n) acc[n] = (f32x4){0.f, 0.f, 0.f, 0.f};
                const bf16_t* qrow = QP + ((size_t)(h * 8 + s * 4 + (fq >> 1)) * M + r0 + tok) * 16 + (fq & 1) * 8;
                const bf16x8 a0 = *(const bf16x8*)(qrow), a1 = *(const bf16x8*)(qrow + (size_t)2 * M * 16);
                const bf16_t* kb = SK + (size_t)((h * 2 + s) * 128 + tok) * 64 + fq * 8;
                const LAS unsigned char* kl = lds + 65536 + (((hh * 2 + s) * 128 + tok) * 72 + fq * 8) * 2;
                if (use_lds) {
#pragma unroll
                    for (int n = 0; n < 8; ++n) {
                        const bf16x8 b0 = *(const LAS bf16x8*)(kl + n * 16 * 144), b1 = *(const LAS bf16x8*)(kl + n * 16 * 144 + 64);
                        acc[n] = __builtin_amdgcn_mfma_f32_16x16x32_bf16(b0, a0, acc[n], 0, 0, 0);
                        acc[n] = __builtin_amdgcn_mfma_f32_16x16x32_bf16(b1, a1, acc[n], 0, 0, 0);
                    }
                } else {
#pragma unroll
                    for (int n = 0; n < 8; ++n) {
                        const bf16x8 b0 = *(const bf16x8*)(kb + n * 16 * 64), b1 = *(const bf16x8*)(kb + n * 16 * 64 + 32);
                        acc[n] = __builtin_amdgcn_mfma_f32_16x16x32_bf16(b0, a0, acc[n], 0, 0, 0);
                        acc[n] = __builtin_amdgcn_mfma_f32_16x16x32_bf16(b1, a1, acc[n], 0, 0, 0);
                    }
                }
                unsigned x[16], y[16];
#pragma unroll
                for (int n = 0; n < 4; ++n)
#pragma unroll
                    for (int r = 0; r < 4; ++r) {
                        x[n * 4 + r] = (f2ord(acc[n][r]) & ~127u) | (unsigned)(127 - (n * 16 + fq * 4 + r));
                        y[n * 4 + r] = (f2ord(acc[n + 4][r]) & ~127u) | (unsigned)(127 - ((n + 4) * 16 + fq * 4 + r));
                    }
                sort16_desc(x); sort16_desc(y); merge_top16(x, y);
#pragma unroll
                for (int i = 0; i < 16; ++i) y[i] = (unsigned)__shfl_xor((int)x[i], 16);
                merge_top16(x, y);
#pragma unroll
                for (int i = 0; i < 16; ++i) y[i] = (unsigned)__shfl_xor((int)x[i], 32);
                merge_top16(x, y);
                if (hp == fq) {
#pragma unroll
                    for (int i = 0; i < 16; ++i) { if (s == 0) LA0[hh][i] = x[i]; else LB0[hh][i] = x[i]; }
                }
            }
          }
        }
        if (fq >= hp_lo && fq < hp_hi)
#pragma unroll
        for (int hh = 0; hh < 2; ++hh) {
            const int head = fq * 2 + hh;
            float af[16], bfv[16];
#pragma unroll
            for (int i = 0; i < 16; ++i) {
                myl[i * 64] = LA0[hh][i]; myl[(16 + i) * 64] = LB0[hh][i];
                af[i] = ord2f(LA0[hh][i] & ~127u); bfv[i] = ord2f(LB0[hh][i] & ~127u);
            }
            unsigned c[4][16];
#pragma unroll
            for (int n = 0; n < 64; ++n) {
                unsigned key = 0u;
                if (CANDS.i[n] >= 0) key = (f2ord(af[CANDS.i[n] < 0 ? 0 : CANDS.i[n]] + bfv[CANDS.j[n] < 0 ? 0 : CANDS.j[n]]) & ~255u) | (unsigned)(255 - (CANDS.i[n] * 16 + CANDS.j[n]));
                c[n >> 4][n & 15] = key;
            }
            sort16_desc(c[0]); sort16_desc(c[1]); sort16_desc(c[2]); sort16_desc(c[3]);
            merge_top16(c[0], c[1]); merge_top16(c[2], c[3]); merge_top16(c[0], c[2]);
            float sc[16], se = 0.f; int eidx[16];
#pragma unroll
            for (int k = 0; k < 16; ++k) {
                const unsigned code = 255u - (c[0][k] & 255u);
                const unsigned ka = myl[(code >> 4) * 64], kbv = myl[(16 + (code & 15u)) * 64];
                eidx[k] = (int)((127u - (ka & 127u)) * 128u + (127u - (kbv & 127u)));
                sc[k] = ord2f(c[0][k] & ~255u);
            }
            const float mx = sc[0];
#pragma unroll
            for (int k = 0; k < 16; ++k) { sc[k] = __expf(sc[k] - mx); se += sc[k]; }
            const float inv = 1.f / se;
#pragma unroll
            for (int k = 0; k < 16; ++k) sc[k] *= inv;
            int* ip = IDX + (size_t)(r0 + tok) * 128 + head * 16; float* gp = GATE + (size_t)(r0 + tok) * 128 + head * 16;
#pragma unroll
            for (int k = 0; k < 16; k += 4) { *(int4*)(ip + k) = make_int4(eidx[k], eidx[k + 1], eidx[k + 2], eidx[k + 3]); }
#pragma unroll
            for (int k = 0; k < 16; k += 4) { *(float4*)(gp + k) = make_float4(sc[k], sc[k + 1], sc[k + 2], sc[k + 3]); }
        }
    }
}

__device__ __forceinline__ u32x4 row8_load(const unsigned char* T, int idx, int lane) { return *(const u32x4*)(T + (unsigned)(idx * D + lane * 16)); }
__device__ __forceinline__ float row8_dot(const u32x4& r, const f32x2 (&hv)[8]) {
    f32x2 acc = (f32x2){0.f, 0.f};
#pragma unroll
    for (int i = 0; i < 4; ++i) {
        acc += __builtin_amdgcn_cvt_pk_f32_fp8((int)r[i], false) * hv[2 * i];
        acc += __builtin_amdgcn_cvt_pk_f32_fp8((int)r[i], true) * hv[2 * i + 1];
    }
    return acc[0] + acc[1];
}
__device__ __forceinline__ void row8_axpy(f32x2 (&o)[8], const u32x4& r, float w) {
    const f32x2 w2 = (f32x2){w, w};
#pragma unroll
    for (int i = 0; i < 4; ++i) {
        o[2 * i] += w2 * __builtin_amdgcn_cvt_pk_f32_fp8((int)r[i], false);
        o[2 * i + 1] += w2 * __builtin_amdgcn_cvt_pk_f32_fp8((int)r[i], true);
    }
}
__device__ __forceinline__ float rl_f(float v, int l) { return __uint_as_float(__builtin_amdgcn_readlane(__float_as_uint(v), l)); }
struct GTok { int i0, i1; float dv[2]; float W[2]; f32x2 o[8]; };
struct GEnv { const unsigned char* PU; const unsigned char* PV; const float* SCU; const float* SCV; const bf16_t* H; const int* IDX; const float* GATE; };
__device__ __forceinline__ void gtok_setup(GTok& t, const GEnv& e, int row, int lane, LAS unsigned* sl, u32x4 (&hp)[2]) {
    t.i0 = e.IDX[(size_t)row * 128 + lane]; t.i1 = e.IDX[(size_t)row * 128 + 64 + lane];
    const float su0 = e.SCU[t.i0], su1 = e.SCU[t.i1];
    const float gv0 = e.GATE[(size_t)row * 128 + lane] * e.SCV[t.i0], gv1 = e.GATE[(size_t)row * 128 + 64 + lane] * e.SCV[t.i1];
    {
        const int b0 = t.i0 >> 10, b1 = t.i1 >> 10;
        int base = 0, pos0 = 0, pos1 = 0;
#pragma unroll 4
        for (int k = 0; k < 16; ++k) {
            const unsigned long long m0 = __ballot(b0 == k), m1 = __ballot(b1 == k);
            const int c0 = __popcll(m0);
            const int r0 = __builtin_amdgcn_mbcnt_hi((unsigned)(m0 >> 32), __builtin_amdgcn_mbcnt_lo((unsigned)m0, 0u));
            const int r1 = __builtin_amdgcn_mbcnt_hi((unsigned)(m1 >> 32), __builtin_amdgcn_mbcnt_lo((unsigned)m1, 0u));
            if (b0 == k) pos0 = base + r0;
            if (b1 == k) pos1 = base + c0 + r1;
            base += c0 + __popcll(m1);
        }
        sl[pos0] = (unsigned)t.i0; sl[128 + pos0] = __float_as_uint(su0); sl[256 + pos0] = __float_as_uint(gv0);
        sl[pos1] = (unsigned)t.i1; sl[128 + pos1] = __float_as_uint(su1); sl[256 + pos1] = __float_as_uint(gv1);
        t.i0 = (int)sl[lane]; t.i1 = (int)sl[64 + lane];
    }
    hp[0] = *(const u32x4*)(e.H + (size_t)row * D + lane * 16); hp[1] = *(const u32x4*)(e.H + (size_t)row * D + lane * 16 + 8);
    t.dv[0] = 0.f; t.dv[1] = 0.f;
}
__device__ __forceinline__ void gtok_weights(GTok& t, int lane, const LAS unsigned* sl) {
#pragma unroll
    for (int hf = 0; hf < 2; ++hf) {
        const int ex = 64 * hf + 16 * (lane & 3) + (lane >> 2);
        const float su = __uint_as_float(sl[128 + ex]), gw = __uint_as_float(sl[256 + ex]);
        t.W[hf] = gw * gelu_erf_f(su * t.dv[hf]);
    }
}
__device__ __forceinline__ void gather_epilogue(const Ctx& p, int l, int row, int lane, const f32x2 (&o)[8], const float* modv) {
    float* xr = (row < ML ? p.out() + (size_t)row * D : (float*)(p.ws() + OFF_XC) + (size_t)(row - ML) * D) + lane * 16;
    const float* g2 = modv + (size_t)mod_index(row) * 6144 + 5120 + lane * 16;
    const float* gn = (l == DEPTH - 1) ? p.in(I_FNG) + lane * 16 : p.in(I_N1G) + (l + 1) * D + lane * 16;
    const float* mv = modv + 3 * 6144 + (size_t)mod_index(row) * 6144 + lane * 16;
    f32x4 xa[4], ga[4], gq[4], sh[4], sc[4];
#pragma unroll
    for (int i = 0; i < 4; ++i) { xa[i] = *(const f32x4*)(xr + i * 4); ga[i] = *(const f32x4*)(g2 + i * 4); gq[i] = *(const f32x4*)(gn + i * 4); }
    if (l < DEPTH - 1) {
#pragma unroll
        for (int i = 0; i < 4; ++i) { sh[i] = *(const f32x4*)(mv + i * 4); sc[i] = *(const f32x4*)(mv + 1024 + i * 4); }
    }
    f32x4 xv[4];
#pragma unroll
    for (int i = 0; i < 4; ++i) xv[i] = xa[i] + ga[i] * (f32x4){o[2 * i][0], o[2 * i][1], o[2 * i + 1][0], o[2 * i + 1][1]};
    float ss = 0.f;
#pragma unroll
    for (int i = 0; i < 4; ++i) ss += xv[i][0] * xv[i][0] + xv[i][1] * xv[i][1] + xv[i][2] * xv[i][2] + xv[i][3] * xv[i][3];
    ss = wave_sum(ss);
    const float rstd = rsqrtf(ss * (1.f / 1024.f) + EPS);
    if (l == DEPTH - 1) {
#pragma unroll
        for (int i = 0; i < 4; ++i) *(f32x4*)(xr + i * 4) = xv[i] * rstd * gq[i];
    } else {
#pragma unroll
        for (int i = 0; i < 4; ++i) *(f32x4*)(xr + i * 4) = xv[i];
        u32x4 o0, o1;
#pragma unroll
        for (int i = 0; i < 4; ++i) {
            const f32x4 hq = xv[i] * rstd * gq[i] * (sc[i] + 1.f) + sh[i];
            const unsigned w0 = pack_bf16(hq[0], hq[1]), w1 = pack_bf16(hq[2], hq[3]);
            if (i < 2) { o0[2 * i] = w0; o0[2 * i + 1] = w1; } else { o1[2 * (i - 2)] = w0; o1[2 * (i - 2) + 1] = w1; }
        }
        bf16_t* hp = (bf16_t*)(p.ws() + OFF_H) + (size_t)row * D + lane * 16;
        *(u32x4*)hp = o0; *(u32x4*)(hp + 8) = o1;
    }
}
template <bool four>
__device__ __forceinline__ void gather_item(const Ctx& p, int l, const GEnv& e, const float* modv, LAS unsigned char* glds, LAS unsigned* sl, int wid, int lane,
                                            bool quarter, int rowA, int rowB, int rowC, int rowD, int ng, int gA0, int gB0) {
        GTok A, B, C, E;
        u32x4 hA[2], hB[2], hC[2], hE[2];
        gtok_setup(A, e, rowA, lane, sl, hA);
        __builtin_amdgcn_sched_barrier(0);
        gtok_setup(B, e, rowB, lane, sl + 384, hB);
        __builtin_amdgcn_sched_barrier(0);
        if constexpr (four) {
            gtok_setup(C, e, rowC, lane, sl + 768, hC);
            __builtin_amdgcn_sched_barrier(0);
            gtok_setup(E, e, rowD, lane, sl + 1152, hE);
            __builtin_amdgcn_sched_barrier(0);
        }
        {
            u32x4 ua[4], ub[4];
            float pp[16];
#define U_LOAD(U, T, E0) { const int _is = (E0) < 64 ? T.i0 : T.i1; _Pragma("unroll") for (int j = 0; j < 4; ++j) U[j] = row8_load(e.PU, __builtin_amdgcn_readlane(_is, ((E0) + j) & 63), lane); }
#define U_DOT(U, T, O) { _Pragma("unroll") for (int j = 0; j < 4; ++j) { pp[(O) + j] = row8_dot(U[j], hvc); if (j & 1) __builtin_amdgcn_sched_barrier(0); } }
#define U_FLY(T, G) { const bool b5 = (lane & 32) != 0, b4 = (lane & 16) != 0, b3 = (lane & 8) != 0, b2 = (lane & 4) != 0; \
                float q8[8], q4[4], q2[2], q1; \
                _Pragma("unroll") for (int i = 0; i < 8; ++i) { const float keep = b5 ? pp[i + 8] : pp[i], send = b5 ? pp[i] : pp[i + 8]; q8[i] = keep + __shfl_xor(send, 32); } \
                _Pragma("unroll") for (int i = 0; i < 4; ++i) { const float keep = b4 ? q8[i + 4] : q8[i], send = b4 ? q8[i] : q8[i + 4]; q4[i] = keep + __shfl_xor(send, 16); } \
                _Pragma("unroll") for (int i = 0; i < 2; ++i) { const float keep = b3 ? q4[i + 2] : q4[i], send = b3 ? q4[i] : q4[i + 2]; q2[i] = keep + __shfl_xor(send, 8); } \
                { const float keep = b2 ? q2[1] : q2[0], send = b2 ? q2[0] : q2[1]; q1 = keep + __shfl_xor(send, 4); } \
                q1 += __shfl_xor(q1, 2); q1 += __shfl_xor(q1, 1); \
                const bool mine = (lane & 3) == ((G) & 3); \
                if ((G) < 4) T.dv[0] = mine ? q1 : T.dv[0]; else T.dv[1] = mine ? q1 : T.dv[1]; }
#define U_GROUP(T, HS, G, NEXT) { f32x2 hvc[8]; _Pragma("unroll") for (int i = 0; i < 4; ++i) { hvc[i] = (f32x2){__uint_as_float(HS[0][i] << 16), __uint_as_float(HS[0][i] & 0xFFFF0000u)}; \
                hvc[4 + i] = (f32x2){__uint_as_float(HS[1][i] << 16), __uint_as_float(HS[1][i] & 0xFFFF0000u)}; } \
                U_LOAD(ub, T, (G) * 16 + 4) __builtin_amdgcn_sched_barrier(0); U_DOT(ua, T, 0) __builtin_amdgcn_sched_barrier(0); \
                U_LOAD(ua, T, (G) * 16 + 8) __builtin_amdgcn_sched_barrier(0); U_DOT(ub, T, 4) __builtin_amdgcn_sched_barrier(0); \
                U_LOAD(ub, T, (G) * 16 + 12) __builtin_amdgcn_sched_barrier(0); U_DOT(ua, T, 8) __builtin_amdgcn_sched_barrier(0); \
                NEXT __builtin_amdgcn_sched_barrier(0); U_DOT(ub, T, 12) U_FLY(T, G) }
            U_LOAD(ua, A, gA0 * 16)
#pragma unroll 1
            for (int gi = 0; gi < ng; ++gi) {
                const int gA = gA0 + gi, gB = gB0 + gi;
                U_GROUP(A, hA, gA, U_LOAD(ua, B, gB * 16))
                U_GROUP(B, hB, gB, if constexpr (four) U_LOAD(ua, C, gA * 16) else if (gi + 1 < ng) U_LOAD(ua, A, gA * 16 + 16))
                if constexpr (four) {
                    U_GROUP(C, hC, gA, U_LOAD(ua, E, gA * 16))
                    U_GROUP(E, hE, gA, if (gi + 1 < ng) U_LOAD(ua, A, gA * 16 + 16))
                }
            }
#undef U_LOAD
#undef U_DOT
#undef U_FLY
#undef U_GROUP
        }
        __builtin_amdgcn_sched_barrier(0);
        gtok_weights(A, lane, sl);
        gtok_weights(B, lane, sl + 384);
        LAS float* wpark = (LAS float*)(glds + 98304) + wid * 256 + lane;
        if constexpr (four) {
            gtok_weights(C, lane, sl + 768); gtok_weights(E, lane, sl + 1152);
            wpark[0] = C.W[0]; wpark[64] = C.W[1]; wpark[128] = E.W[0]; wpark[192] = E.W[1];
        }
        __builtin_amdgcn_sched_barrier(0);
        auto pair2 = [&](GTok& X, GTok& Y, const int rowX, const int rowY) {
            {
#pragma unroll
                for (int i = 0; i < 8; ++i) { X.o[i] = (f32x2){0.f, 0.f}; Y.o[i] = (f32x2){0.f, 0.f}; }
                u32x4 va[4], vb[4];
#define V_LOAD(V, T, E0) { const int _is = (E0) < 64 ? T.i0 : T.i1; _Pragma("unroll") for (int j = 0; j < 4; ++j) V[j] = row8_load(e.PV, __builtin_amdgcn_readlane(_is, ((E0) + j) & 63), lane); }
#define V_ACC(V, T, E0) { const float _w = (E0) < 64 ? T.W[0] : T.W[1]; _Pragma("unroll") for (int j = 0; j < 4; ++j) { const int _e = ((E0) + j) & 63; \
                row8_axpy(T.o, V[j], rl_f(_w, ((_e & 15) << 2) | (_e >> 4))); if (j & 1) __builtin_amdgcn_sched_barrier(0); } }
#define V_GROUP(T, G, NEXT) { \
                V_LOAD(vb, T, (G) * 16 + 4) __builtin_amdgcn_sched_barrier(0); V_ACC(va, T, (G) * 16) __builtin_amdgcn_sched_barrier(0); \
                V_LOAD(va, T, (G) * 16 + 8) __builtin_amdgcn_sched_barrier(0); V_ACC(vb, T, (G) * 16 + 4) __builtin_amdgcn_sched_barrier(0); \
                V_LOAD(vb, T, (G) * 16 + 12) __builtin_amdgcn_sched_barrier(0); V_ACC(va, T, (G) * 16 + 8) __builtin_amdgcn_sched_barrier(0); \
                NEXT __builtin_amdgcn_sched_barrier(0); V_ACC(vb, T, (G) * 16 + 12) }
                V_LOAD(va, X, gA0 * 16)
#pragma unroll 1
                for (int gi = 0; gi < ng; ++gi) {
                    const int gA = gA0 + gi, gB = gB0 + gi;
                    V_GROUP(X, gA, V_LOAD(va, Y, gB * 16))
                    V_GROUP(Y, gB, if (gi + 1 < ng) V_LOAD(va, X, gA * 16 + 16))
                }
#undef V_LOAD
#undef V_ACC
#undef V_GROUP
            }
            if constexpr (!four) {
#pragma unroll
                for (int i = 0; i < 8; ++i) X.o[i] += Y.o[i];
                LAS f32x2* part = (LAS f32x2*)(glds + 65536) + (wid * 64 + lane) * 8;
#pragma unroll
                for (int i = 0; i < 8; ++i) part[i] = X.o[i];
                __syncthreads();
                if ((wid & 3) != 0) return;
#pragma unroll
                for (int q = 1; q < 4; ++q) {
                    const LAS f32x2* pq = (const LAS f32x2*)(glds + 65536) + ((wid + q) * 64 + lane) * 8;
#pragma unroll
                    for (int i = 0; i < 8; ++i) X.o[i] += pq[i];
                }
                gather_epilogue(p, l, rowX, lane, X.o, modv);
            } else {
                gather_epilogue(p, l, rowX, lane, X.o, modv);
                gather_epilogue(p, l, rowY, lane, Y.o, modv);
            }
        };
        pair2(A, B, rowA, rowB);
        if constexpr (four) {
            asm volatile("" ::: "memory");
            __builtin_amdgcn_sched_barrier(0);
            GTok C2, E2;
            C2.i0 = (int)sl[768 + lane]; C2.i1 = (int)sl[768 + 64 + lane]; E2.i0 = (int)sl[1152 + lane]; E2.i1 = (int)sl[1152 + 64 + lane];
            C2.W[0] = wpark[0]; C2.W[1] = wpark[64]; E2.W[0] = wpark[128]; E2.W[1] = wpark[192];
            pair2(C2, E2, rowC, rowD);
        }
    }
__device__ __forceinline__ void phase_gather(const Ctx& p, int l, LAS unsigned char* glds) {
    const int tid = tid_opaque(), lane0 = tid & 63, wid = __builtin_amdgcn_readfirstlane(tid >> 6);
    GEnv e;
    e.PU = wsw(p, l) + OFF_PU; e.PV = wsw(p, l) + OFF_PV; e.SCU = (const float*)(wsw(p, l) + OFF_SCU); e.SCV = (const float*)(wsw(p, l) + OFF_SCV);
    e.H = (const bf16_t*)(p.ws() + OFF_H); e.IDX = (const int*)(p.ws() + OFF_IDX); e.GATE = (const float*)(p.ws() + OFF_GATE);
    const float* modv = (const float*)(p.ws() + OFF_MODV) + (size_t)l * 3 * 6144;
    LAS unsigned* sl = (LAS unsigned*)glds + wid * 1536;
    const int gw = blockIdx.x * 8 + wid, nw = gridDim.x * 8;
    const bool balanced = (nw * 16 == ML) && (MC * 4 == nw);
    const int nitems = balanced ? (l < DEPTH - 1 ? 5 : 4) : 0;
#pragma unroll 1
    for (int it = 0; it < nitems; ++it) {
        int lane = lane0; asm volatile("" : "+v"(lane));
        const bool quarter = it == 4;
        xcd_soft_sync((unsigned*)(p.ws() + OFF_BAR), (volatile LAS unsigned*)(glds + XB_LDS_OFF), (unsigned)(l * 5 + it));
        const int rowA = quarter ? ML + (gw >> 2) : gw + (4 * it) * nw, rowB = quarter ? rowA : gw + (4 * it + 1) * nw;
        const int rowC = gw + ((4 * it + 2) & 15) * nw, rowD = gw + ((4 * it + 3) & 15) * nw;
        const int ng = quarter ? 1 : 8, gA0 = quarter ? 2 * (gw & 3) : 0, gB0 = quarter ? gA0 + 1 : 0;
        if (quarter) gather_item<false>(p, l, e, modv, glds, sl, wid, lane, true, rowA, rowB, rowC, rowD, ng, gA0, gB0);
        else gather_item<true>(p, l, e, modv, glds, sl, wid, lane, false, rowA, rowB, rowC, rowD, ng, gA0, gB0);
    }
    if (!balanced) {
        const int lane = lane0;
        for (int row = gw; row < ((l < DEPTH - 1) ? M : ML); row += nw) {
            u32x4 hA[2];
            GTok A; gtok_setup(A, e, row, lane, sl, hA);
            f32x2 hvc[8];
#pragma unroll
            for (int i = 0; i < 4; ++i) { hvc[i] = (f32x2){__uint_as_float(hA[0][i] << 16), __uint_as_float(hA[0][i] & 0xFFFF0000u)}; hvc[4 + i] = (f32x2){__uint_as_float(hA[1][i] << 16), __uint_as_float(hA[1][i] & 0xFFFF0000u)}; }
#pragma unroll
            for (int i = 0; i < 8; ++i) A.o[i] = (f32x2){0.f, 0.f};
            for (int ee = 0; ee < 128; ++ee) {
                const int idx = __builtin_amdgcn_readlane(ee < 64 ? A.i0 : A.i1, ee & 63);
                const u32x4 ur = row8_load(e.PU, idx, lane), vr = row8_load(e.PV, idx, lane);
                float d = row8_dot(ur, hvc);
                d = wave_sum(d);
                const float w = __uint_as_float(sl[256 + ee]) * gelu_erf_f(__uint_as_float(sl[128 + ee]) * d);
                row8_axpy(A.o, vr, w);
            }
            gather_epilogue(p, l, row, lane, A.o, modv);
        }
    }
}

__device__ __forceinline__ void phase_copy_x(const Ctx& p) {
    const size_t n4 = (size_t)M * D / 4;
    for (size_t i = (size_t)blockIdx.x * NT + threadIdx.x; i < n4; i += (size_t)gridDim.x * NT) {
        const size_t e = i * 4;
        if (e < (size_t)ML * D) *(float4*)(p.out() + e) = *(const float4*)(p.in(I_X) + e);
        else *(float4*)((float*)(p.ws() + OFF_XC) + (e - (size_t)ML * D)) = *(const float4*)(p.in(I_CTX) + (e - (size_t)ML * D));
    }
}

__global__ void __launch_bounds__(NT, 2) fwd_kernel(Params kp) {
    extern __shared__ __attribute__((aligned(16))) unsigned char smem_raw[];
    LAS unsigned char* lds = (LAS unsigned char*)smem_raw;
    if (threadIdx.x == 0) *(LAS u32x4*)(lds + XB_LDS_OFF) = (u32x4){0u, 0u, 0u, 0u};
    __syncthreads();
    XcdBarrier bar = xcd_barrier_post((unsigned*)(kp.ws + OFF_BAR), (volatile LAS unsigned*)(lds + XB_LDS_OFF));
#ifdef LDS_PROBE
    {
        volatile LAS unsigned* hi = (volatile LAS unsigned*)(lds + 90000);
        if (threadIdx.x == 0) *hi = 0xABCD1234u;
        __syncthreads();
        if (threadIdx.x == 64) { const unsigned rb = *hi; if (rb != 0xABCD1234u) atomicAdd((unsigned*)(kp.ws + OFF_BAR) + 8, 1u); }
        __syncthreads();
    }
#endif

#define GRID_BARRIER() do { XcdBarrier _b = bar; asm volatile("" : "+s"(_b.bar), "+s"(_b.x)); xcd_barrier(_b); } while (0)
#ifndef PMASK
#define PMASK 0xFFFF
#endif
#ifndef REPMASK
#define REPMASK 0
#endif
#define RUN(bit, call) do { if (PMASK & (bit)) { int _reps = (REPMASK & (bit)) ? 2 : 1; if (REPMASK) asm volatile("" : "+s"(_reps)); _Pragma("unroll 1") for (int _r = 0; _r < _reps; ++_r) { call; } } } while (0)
    RUN(1, phase_modv(get_ctx(), lds));
    RUN(2, phase_prep(get_ctx(), 0, 128, lds));
    GRID_BARRIER();
    RUN(4, phase_norm(get_ctx(), 0, 0));
    GRID_BARRIER();
    for (int l = 0; l < DEPTH; ++l) {
        RUN(64, phase_g1(get_ctx(), l, lds));
        GRID_BARRIER();
        RUN(128, phase_x1(get_ctx(), l, lds));
        GRID_BARRIER();
        RUN(256, phase_x2(get_ctx(), l, lds));
        if (l + 1 < DEPTH) { RUN(2, phase_prep(get_ctx(), l + 1, 128, lds)); }
        GRID_BARRIER();
        RUN(512, phase_x3(get_ctx(), l, lds));
        GRID_BARRIER();
        RUN(1024, phase_g2(get_ctx(), l, lds));
        GRID_BARRIER();
        if (PMASK & 2048) phase_g3(get_ctx(), l, lds);
        GRID_BARRIER();
        if (PMASK & 4096) phase_g4(get_ctx(), l, lds);
        GRID_BARRIER();
        RUN(4, phase_norm(get_ctx(), l, 1));
        GRID_BARRIER();
        RUN(8, phase_g5(get_ctx(), l, lds));
        GRID_BARRIER();
        RUN(16, phase_select(get_ctx(), l, lds));
        GRID_BARRIER();
        if (PMASK & 32) phase_gather(get_ctx(), l, lds);
        GRID_BARRIER();
    }
}

extern "C" void kernel_launch(void* const* d_in, const int* in_sizes, int n_in, void* d_out, int out_size, void* d_ws, size_t ws_size,
                              hipStream_t stream) {
    static int grid = 0;
    if (!grid) {
        int dev = 0, cus = 0, per_cu = 0;
        (void)hipGetDevice(&dev);
        if (hipDeviceGetAttribute(&cus, hipDeviceAttributeMultiprocessorCount, dev) != hipSuccess || cus <= 0) cus = 256;
        if (hipFuncSetAttribute((const void*)fwd_kernel, hipFuncAttributeMaxDynamicSharedMemorySize, LDS_BYTES) != hipSuccess)
            fprintf(stderr, "kernel_launch: hipFuncSetAttribute failed\n");
        if (hipOccupancyMaxActiveBlocksPerMultiprocessor(&per_cu, (const void*)fwd_kernel, NT, LDS_BYTES) != hipSuccess || per_cu < 1)
            fprintf(stderr, "kernel_launch: note: occupancy query reports %d workgroups per CU\n", per_cu);
        (void)hipGetLastError();
        grid = 256;
        if (cus != 256) fprintf(stderr, "kernel_launch: note: device reports %d CUs; the kernel is laid out for 256\n", cus);
        if (ws_size < WS_TOTAL) fprintf(stderr, "kernel_launch: workspace too small: %zu < %zu\n", ws_size, (size_t)WS_TOTAL);
    }
    (void)hipMemsetAsync((unsigned char*)d_ws + OFF_BAR, 0, 16384, stream);
    Params p{};
    for (int i = 0; i < 30; ++i) p.in[i] = (const float*)d_in[i];
    p.out = (float*)d_out; p.ws = (unsigned char*)d_ws;
    fwd_kernel<<<dim3(grid), dim3(NT), LDS_BYTES, stream>>>(p);
}
```

```cpp
#include <hip/hip_runtime.h>
#include <stdint.h>
#include <stdio.h>

#define ENABLE_PEER 1

#define LAS __attribute__((address_space(3)))
typedef unsigned short bf16_t;
typedef short bf16x8 __attribute__((ext_vector_type(8)));
typedef float f32x4 __attribute__((ext_vector_type(4)));
typedef __bf16 bf16x2 __attribute__((ext_vector_type(2)));
typedef unsigned u32x4 __attribute__((ext_vector_type(4)));
typedef unsigned u32x2 __attribute__((ext_vector_type(2)));
typedef float f32x2 __attribute__((ext_vector_type(2)));

constexpr int D = 1024, NB = 2, SEQ = 16384, CTX = 256, DEPTH = 4;
constexpr int ML = NB * SEQ, MC = NB * CTX, M = ML + MC;
constexpr int TS = SEQ + CTX;
constexpr int INC = 4608;
constexpr int NEXP = 16384;
constexpr float EPS = 1e-6f;
constexpr int NT = 512;

enum { I_X = 0, I_C, I_CTX, I_CCTX, I_WMOD, I_BMOD, I_N1G, I_N2G, I_WIN, I_BRE, I_BIM, I_CRE, I_CIM, I_SSMD, I_LREF, I_LIMF, I_LDTF,
       I_LREB, I_LIMB, I_LDTB, I_WGLU, I_RDF, I_RDB, I_WRU, I_WOUT, I_WQ, I_SKEY, I_PU, I_PV, I_FNG };

struct Params { const float* in[30]; float* out; unsigned char* ws; };
#define AS4 __attribute__((address_space(4)))
struct Ctx {
    const AS4 unsigned long long* ka;
    __device__ __forceinline__ const float* in(int i) const { return (const float*)(const __attribute__((address_space(1))) float*)ka[i]; }
    __device__ __forceinline__ float* out() const { return (float*)(__attribute__((address_space(1))) float*)ka[30]; }
    __device__ __forceinline__ unsigned char* ws() const { return (unsigned char*)(__attribute__((address_space(1))) unsigned char*)ka[31]; }
};
__device__ __forceinline__ unsigned char* wsw(const Ctx& p, int l);
__device__ __forceinline__ Ctx get_ctx() {
    const AS4 unsigned long long* ka = (const AS4 unsigned long long*)__builtin_amdgcn_kernarg_segment_ptr();
    asm volatile("" : "+s"(ka));
    return Ctx{ka};
}

constexpr size_t al(size_t x) { return (x + 4095) & ~(size_t)4095; }
constexpr size_t OFF_BAR   = 0;
constexpr size_t OFF_MODV  = 16384;
constexpr size_t OFF_ROPE  = al(OFF_MODV + (size_t)4 * 3 * 6144 * 4);
constexpr size_t OFF_S5AT  = al(OFF_ROPE + (size_t)(256 * 32 * 2 + 64 * 32 * 2) * 4);
constexpr size_t OFF_SCU   = al(OFF_S5AT + (size_t)32 * 2 * 64 * 2 * 4);
constexpr size_t OFF_SCV   = al(OFF_SCU + (size_t)NEXP * 4);
constexpr size_t OFF_WINT  = al(OFF_SCV + (size_t)NEXP * 4);
constexpr size_t OFF_WGLUT = al(OFF_WINT + (size_t)INC * D * 2);
constexpr size_t OFF_WRUT  = al(OFF_WGLUT + (size_t)2048 * 512 * 2);
constexpr size_t OFF_WOUTT = al(OFF_WRUT + (size_t)1024 * 512 * 2);
constexpr size_t OFF_WQT   = al(OFF_WOUTT + (size_t)D * D * 2);
constexpr size_t OFF_SKEY  = al(OFF_WQT + (size_t)D * D * 2);
constexpr size_t OFF_PU    = al(OFF_SKEY + (size_t)16 * 128 * 64 * 2);
constexpr size_t OFF_PV    = al(OFF_PU + (size_t)NEXP * D);
constexpr size_t OFF_S5W   = al(OFF_PV + (size_t)NEXP * D);
constexpr size_t OFF_S5TV  = al(OFF_S5W + (size_t)32 * 256 * 512 * 2);
constexpr size_t WBLK      = al(OFF_S5TV + (size_t)32 * 512 * 768 * 2) - OFF_S5AT;
constexpr size_t OFF_XC    = OFF_S5AT + 2 * WBLK;
constexpr size_t OFF_H     = al(OFF_XC + (size_t)MC * D * 4);
constexpr size_t OFF_U     = al(OFF_H + (size_t)M * D * 2);
constexpr size_t OFF_Q     = al(OFF_U + (size_t)M * 512 * 2);
constexpr size_t OFF_K     = al(OFF_Q + (size_t)M * 512 * 2);
constexpr size_t OFF_G     = al(OFF_K + (size_t)M * 512 * 2);
constexpr size_t OFF_KTF   = al(OFF_G + (size_t)M * 512 * 2);
constexpr size_t OFF_KTB   = al(OFF_KTF + (size_t)NB * 4 * 128 * TS * 2);
constexpr size_t OFF_VT    = al(OFF_KTB + (size_t)NB * 4 * 128 * TS * 2);
constexpr size_t OFF_GS    = al(OFF_VT + (size_t)NB * 4 * 128 * TS * 2);
constexpr size_t OFF_GR    = al(OFF_GS + (size_t)M * D * 2);
constexpr size_t OFF_SBUF  = al(OFF_GR + (size_t)M * D * 2);
constexpr size_t OFF_HIN   = al(OFF_SBUF + (size_t)32 * 1040 * 256 * 4);
constexpr size_t OFF_YS    = al(OFF_HIN + (size_t)32 * 1040 * 256 * 2);
constexpr size_t OFF_KV    = al(OFF_YS + (size_t)M * 512 * 2);
constexpr size_t OFF_SBEF  = al(OFF_KV + (size_t)NB * 4 * 2 * 130 * 16384 * 2);
constexpr size_t OFF_YR    = al(OFF_SBEF + (size_t)NB * 4 * 2 * 130 * 16384 * 2);
constexpr size_t OFF_PBUF  = al(OFF_YR + (size_t)M * 512 * 2);
constexpr size_t OFF_AS5   = al(OFF_PBUF + (size_t)256 * 128 * 128 * 2);
constexpr size_t WS_TOTAL  = al(OFF_AS5 + (size_t)32 * 1040 * 768 * 2);
constexpr size_t OFF_QP    = OFF_GS;
constexpr size_t OFF_IDX   = OFF_GR;
constexpr size_t OFF_GATE  = OFF_GR + (size_t)M * 128 * 4;

__device__ __forceinline__ unsigned char* wsw(const Ctx& p, int l) { return p.ws() + (size_t)(l & 1) * WBLK; }
__device__ __forceinline__ float bf2f(unsigned short u) { return __uint_as_float(((unsigned)u) << 16); }
__device__ __forceinline__ unsigned pack_bf16(float lo, float hi) { bf16x2 v; v[0] = (__bf16)lo; v[1] = (__bf16)hi; return __builtin_bit_cast(unsigned, v); }
__device__ __forceinline__ float wave_sum(float v) {
#pragma unroll
    for (int o = 32; o > 0; o >>= 1) v += __shfl_xor(v, o);
    return v;
}
__device__ __forceinline__ float rcp_f(float v) { return __builtin_amdgcn_rcpf(v); }
__device__ __forceinline__ float silu_f(float v) { return v * rcp_f(1.f + __expf(-v)); }
__device__ __forceinline__ float sigmoid_f(float v) { return rcp_f(1.f + __expf(-v)); }
__device__ __forceinline__ float gelu_tanh_f(float v) { const float u = 0.7978845608028654f * (v + 0.044715f * v * v * v); return v * rcp_f(1.f + __expf(-2.f * u)); }
__device__ __forceinline__ float gelu_erf_f(float v) { return 0.5f * v * (1.f + erff(v * 0.7071067811865476f)); }
__device__ __forceinline__ float dot2bf(unsigned a, unsigned b, float c) { return __builtin_amdgcn_fdot2_f32_bf16(__builtin_bit_cast(bf16x2, a), __builtin_bit_cast(bf16x2, b), c, false); }
__device__ __forceinline__ int tid_opaque() { int t = threadIdx.x; asm volatile("" : "+v"(t)); return t; }
__device__ __forceinline__ int mod_index(int row) { return row < ML ? (row >> 14) : 2; }

#define XB_TMO      128
#define XB_XCNT(j)  (256  + 64 * (j))
#define XB_XSUB(j)  (1280 + 64 * (j))
#define XB_XGEN(j)  (2304 + 64 * (j))
#define XB_TOP      3328
#define XB_TOPGEN   3392
#define XCD_BAR_WORDS 3456
#define XB_SPIN_CAP (1u << 18)

typedef __attribute__((address_space(1))) unsigned gu32;
__device__ __forceinline__ unsigned xb_ld(unsigned* p)              { return __hip_atomic_load((gu32*)p, __ATOMIC_RELAXED, __HIP_MEMORY_SCOPE_AGENT); }
__device__ __forceinline__ unsigned xb_add(unsigned* p, unsigned v) { return __hip_atomic_fetch_add((gu32*)p, v, __ATOMIC_RELAXED, __HIP_MEMORY_SCOPE_AGENT); }
__device__ __forceinline__ unsigned xb_xcc_id() { return (unsigned)__builtin_amdgcn_s_getreg((3 << 11) | 20) & 0xFu; }
#define XB_SPIN(cond, bar) do { unsigned _sp = 0; while (cond) { __builtin_amdgcn_s_sleep(1); \
    if ((++_sp & 255u) == 0u) { if (xb_ld(&(bar)[XB_TMO])) break; if (_sp > XB_SPIN_CAP) { atomicAdd(&(bar)[XB_TMO], 1u); break; } } } } while (0)

struct XcdBarrier { unsigned* bar; unsigned x; volatile LAS unsigned* st; };

__device__ __forceinline__ XcdBarrier xcd_barrier_post(unsigned* bar, volatile LAS unsigned* st) {
    XcdBarrier b; b.bar = bar; b.x = xb_xcc_id(); b.st = st;
    if (threadIdx.x == 0) (void)xb_add(&bar[XB_XCNT(b.x)], 1u);
    return b;
}
__device__ __forceinline__ void xcd_barrier_complete(unsigned* bar, unsigned x, unsigned& nloc, unsigned& nx) {
    const unsigned G = gridDim.x * gridDim.y * gridDim.z;
    unsigned sum, cnt, mine, sp = 0u;
    for (;;) {
        sum = 0u; cnt = 0u; mine = 0u;
#pragma unroll
        for (unsigned j = 0; j < 16; ++j) { const unsigned c = xb_ld(&bar[XB_XCNT(j)]); sum += c; cnt += (c > 0u) ? 1u : 0u; mine = (j == x) ? c : mine; }
        if (sum == G) break;
        __builtin_amdgcn_s_sleep(1);
        if ((++sp & 255u) == 0u) { if (xb_ld(&bar[XB_TMO])) break; if (sp > XB_SPIN_CAP) { atomicAdd(&bar[XB_TMO], 1u); break; } }
    }
    nloc = mine > 0u ? mine : 1u; nx = cnt > 0u ? cnt : 1u;
}
__device__ __forceinline__ void xcd_barrier(const XcdBarrier& b) {
    asm volatile("s_waitcnt vmcnt(0)" ::: "memory");
    __syncthreads();
    if (threadIdx.x == 0) {
        unsigned* bar = b.bar;
        __builtin_amdgcn_s_waitcnt(0);
        unsigned nloc = b.st[0], nx = b.st[1];
        if (nloc == 0u) { xcd_barrier_complete(bar, b.x, nloc, nx); b.st[0] = nloc; b.st[1] = nx; }
        const unsigned old = xb_add(&bar[XB_XSUB(b.x)], 1u);
        const unsigned gen = old / nloc;
        if (old + 1u == (gen + 1u) * nloc) {
            __builtin_amdgcn_fence(__ATOMIC_RELEASE, "agent");
            asm volatile("s_waitcnt vmcnt(0)" ::: "memory");
            const unsigned og = xb_add(&bar[XB_TOP], 1u);
            const unsigned tg = og / nx;
            if (og + 1u == (tg + 1u) * nx) xb_add(&bar[XB_TOPGEN], 1u);
            else XB_SPIN(xb_ld(&bar[XB_TOPGEN]) == tg, bar);
            __builtin_amdgcn_fence(__ATOMIC_ACQUIRE, "agent");
            xb_add(&bar[XB_XGEN(b.x)], 1u);
            asm volatile("s_waitcnt vmcnt(0)" ::: "memory");
        } else {
            XB_SPIN(xb_ld(&bar[XB_XGEN(b.x)]) == gen, bar);
            __builtin_amdgcn_fence(__ATOMIC_ACQUIRE, "agent");
            asm volatile("s_waitcnt vmcnt(0)" ::: "memory");
        }
    }
    __syncthreads();
}


#define GS_CNT(j) (3520 + 64 * ((j) & 7))
#ifndef SOFT_SYNC
#define SOFT_SYNC 1
#endif
__device__ __forceinline__ void xcd_soft_sync(unsigned* bar, volatile LAS unsigned* st, unsigned step) {
#if SOFT_SYNC
    if (threadIdx.x == 0) {
        const unsigned x = xb_xcc_id(), nloc = st[0];
        if (nloc != 0u) {
            const unsigned target = nloc * (step + 1u);
            (void)xb_add(&bar[GS_CNT(x)], 1u);
            for (int sp = 0; sp < 4000; ++sp) { if (xb_ld(&bar[GS_CNT(x)]) >= target) break; __builtin_amdgcn_s_sleep(2); }
        }
    }
    __syncthreads();
#endif
}
constexpr int LROW = 72;
constexpr int TILE_LDS = 128 * LROW * 2;
constexpr int MMA_LDS = 4 * TILE_LDS;
constexpr int LDS_BYTES = 147456;
constexpr int XB_LDS_OFF = LDS_BYTES - 16;
constexpr int PP = 136;
constexpr int P_LDS_OFF = MMA_LDS;
constexpr int RED_LDS_OFF = P_LDS_OFF + 128 * PP * 2;

template <bool SW, bool ALDS, class LA, class LB>
__device__ __forceinline__ void mma_tile_g(f32x4 (&acc)[4][2], const LA& la, const LB& lb, const int K, LAS unsigned char* lds) {
    const int tid = tid_opaque(), lane = tid & 63, wid = __builtin_amdgcn_readfirstlane(tid >> 6), wm = wid >> 2, wn = wid & 3;
    const int lr = tid >> 3, lk = (tid & 7) * 8;
    const int nkt = K >> 6;
    u32x4 ra0, ra1, rb0, rb1;
    if (!ALDS) { ra0 = *(const u32x4*)la(lr, lk); ra1 = *(const u32x4*)la(lr + 64, lk); }
    rb0 = *(const u32x4*)lb(lr, lk); rb1 = *(const u32x4*)lb(lr + 64, lk);
    const int woff = (lr * LROW + lk) * 2;
    {
        LAS unsigned char* Ab = lds; LAS unsigned char* Bb = lds + TILE_LDS;
        if (!ALDS) { *(LAS u32x4*)(Ab + woff) = ra0; *(LAS u32x4*)(Ab + woff + 64 * LROW * 2) = ra1; }
        *(LAS u32x4*)(Bb + woff) = rb0; *(LAS u32x4*)(Bb + woff + 64 * LROW * 2) = rb1;
    }
    __syncthreads();
    const int aoff = ALDS ? P_LDS_OFF + ((wm * 64 + (lane & 15)) * PP + (lane >> 4) * 8) * 2 : ((wm * 64 + (lane & 15)) * LROW + (lane >> 4) * 8) * 2;
    const int boff = ((wn * 32 + (lane & 15)) * LROW + (lane >> 4) * 8) * 2;
    for (int kt = 0; kt < nkt; ++kt) {
        const bool more = (kt + 1 < nkt);
        if (more) {
            const int k = (kt + 1) * 64 + lk;
            if (!ALDS) { ra0 = *(const u32x4*)la(lr, k); ra1 = *(const u32x4*)la(lr + 64, k); }
            rb0 = *(const u32x4*)lb(lr, k); rb1 = *(const u32x4*)lb(lr + 64, k);
        }
        LAS unsigned char* Ab = lds + (kt & 1) * 2 * TILE_LDS; LAS unsigned char* Bb = Ab + TILE_LDS;
#pragma unroll
        for (int ks = 0; ks < 2; ++ks) {
            bf16x8 af[4], bfr[2];
#pragma unroll
            for (int mt = 0; mt < 4; ++mt)
                af[mt] = ALDS ? *(const LAS bf16x8*)(lds + aoff + (mt * 16 * PP + kt * 64 + ks * 32) * 2)
                              : *(const LAS bf16x8*)(Ab + aoff + (mt * 16 * LROW + ks * 32) * 2);
#pragma unroll
            for (int nt = 0; nt < 2; ++nt) bfr[nt] = *(const LAS bf16x8*)(Bb + boff + (nt * 16 * LROW + ks * 32) * 2);
#pragma unroll
            for (int mt = 0; mt < 4; ++mt)
#pragma unroll
                for (int nt = 0; nt < 2; ++nt)
                    acc[mt][nt] = SW ? __builtin_amdgcn_mfma_f32_16x16x32_bf16(bfr[nt], af[mt], acc[mt][nt], 0, 0, 0)
                                     : __builtin_amdgcn_mfma_f32_16x16x32_bf16(af[mt], bfr[nt], acc[mt][nt], 0, 0, 0);
        }
        if (more) {
            LAS unsigned char* An = lds + ((kt + 1) & 1) * 2 * TILE_LDS; LAS unsigned char* Bn = An + TILE_LDS;
            if (!ALDS) { *(LAS u32x4*)(An + woff) = ra0; *(LAS u32x4*)(An + woff + 64 * LROW * 2) = ra1; }
            *(LAS u32x4*)(Bn + woff) = rb0; *(LAS u32x4*)(Bn + woff + 64 * LROW * 2) = rb1;
        }
        __syncthreads();
    }
}
template <bool SW, class LA, class LB>
__device__ __forceinline__ void mma_tile(f32x4 (&acc)[4][2], const LA& la, const LB& lb, const int K, LAS unsigned char* lds) {
    mma_tile_g<SW, false>(acc, la, lb, K, lds);
}
__device__ __forceinline__ void zero_acc(f32x4 (&acc)[4][2]) {
#pragma unroll
    for (int a = 0; a < 4; ++a)
#pragma unroll
        for (int b = 0; b < 2; ++b) acc[a][b] = (f32x4){0.f, 0.f, 0.f, 0.f};
}
__device__ __forceinline__ void tile_coords(int id, int nMt, int nNt, int& mt, int& nt) {
    const int per = 16 * nNt, g = id / per, r = id % per, m0 = g * 16, gm = (nMt - m0) < 16 ? (nMt - m0) : 16;
    mt = m0 + r % gm; nt = r / gm;
}


namespace pg8 {
constexpr int BM = 256, BK = 64, HALF = 128, HTB = HALF * BK * 2, STAGE_BYTES = 8 * HTB, NXCD = 8, WGM = 4;
__device__ __forceinline__ int lds_byte(int r, int c) { const int st = (r >> 4) * 2 + (c >> 5), rr = r & 15, cc = c & 31, ob = rr * 64 + cc * 2; return st * 1024 + (ob ^ (((ob >> 9) & 1) << 5)); }
__device__ __forceinline__ void stage_rc(int b, int& R, int& C) { const int st = b / 1024, sb = b % 1024, swz = sb ^ (((sb >> 9) & 1) << 5); R = (st >> 1) * 16 + swz / 64; C = (st & 1) * 32 + (swz % 64) / 2; }
struct Unit { int pm, pn; };
struct Gemm { const bf16_t* A; const bf16_t* Bt; int M, N, K; };
struct StaticOrder {
    int nM, nN, nwg, G, c;
    __device__ void init(int M_, int N_, int G_, int c_) { nM = M_ / BM; nN = N_ / BM; nwg = nM * nN; G = G_; c = c_; }
    __device__ bool next(int i, Unit& u) const {
        const long L = (long)i * G + c; if (L >= nwg) return false;
        int wgid = (int)L; { const int q = nwg / NXCD, r = nwg % NXCD, xcd = wgid % NXCD, off = wgid / NXCD; wgid = (xcd < r ? xcd * (q + 1) : r * (q + 1) + (xcd - r) * q) + off; }
        const int nig = WGM * nN, gid = wgid / nig, fm = gid * WGM, gsz = (nM - fm) < WGM ? (nM - fm) : WGM;
        u.pm = fm + ((wgid % nig) % gsz); u.pn = (wgid % nig) / gsz; return true;
    }
    __device__ __forceinline__ const char* abase(const Gemm& g, const Unit& u) const { return (const char*)g.A + (size_t)u.pm * ((size_t)BM * g.K * 2); }
    __device__ __forceinline__ const char* bbase(const Gemm& g, const Unit& u) const { return (const char*)g.Bt + (size_t)u.pn * ((size_t)BM * g.K * 2); }
};
template <class Epi, class Sched>
__device__ __forceinline__ void gemm_phase(LAS unsigned char* lds, const Gemm g, const Sched& S, const Epi& E) {
    const int tid = tid_opaque(), wid = __builtin_amdgcn_readfirstlane(tid >> 6), lane = tid & 63, wr = wid >> 2, wc = wid & 3, fr = lane & 15, fq = lane >> 4;
    const int K = g.K, nt = K / BK;
    unsigned voffA[2], voffB[2];
#pragma unroll
    for (int i = 0; i < 2; ++i) { int R, C; stage_rc(tid * 16 + i * 8192, R, C); voffA[i] = (unsigned)(R * K + C) * 2u; voffB[i] = voffA[i]; }
    const size_t kstep = (size_t)(BK * 2);
    const size_t hstep = (size_t)HALF * K * 2;
    const unsigned ldsw = (unsigned)wid * 1024u;
    const int aoff = lds_byte(wr * 64 + fr, fq * 8), boff = lds_byte(wc * 32 + fr, fq * 8);
#define PG8_SA(b, h) (((b) * 2 + (h)) * HTB)
#define PG8_SB(b, h) ((4 + (b) * 2 + (h)) * HTB)
#define PG8_STAGE(bufoff, gbase, voff) do { _Pragma("unroll") for (int _i = 0; _i < 2; ++_i) \
        __builtin_amdgcn_global_load_lds((const unsigned*)((const char*)(gbase) + (voff)[_i]), (LAS unsigned*)(lds + (bufoff) + ldsw + _i * 8192), 16, 0, 0); } while (0)
#define PG8_LDA(dst, b, h) do { _Pragma("unroll") for (int m = 0; m < 4; ++m) _Pragma("unroll") for (int k = 0; k < 2; ++k) dst[m][k] = *(const LAS bf16x8*)(lds + PG8_SA(b, h) + aoff + m * 2048 + k * 1024); } while (0)
#define PG8_LDB(dst, b, h) do { _Pragma("unroll") for (int n = 0; n < 2; ++n) _Pragma("unroll") for (int k = 0; k < 2; ++k) dst[n][k] = *(const LAS bf16x8*)(lds + PG8_SB(b, h) + boff + n * 2048 + k * 1024); } while (0)
#define PG8_MMA(ai, bj, At, Bt) do { __builtin_amdgcn_s_setprio(1); _Pragma("unroll") for (int m = 0; m < 4; ++m) _Pragma("unroll") for (int n = 0; n < 2; ++n) _Pragma("unroll") for (int k = 0; k < 2; ++k) \
        acc[ai][bj][m][n] = __builtin_amdgcn_mfma_f32_16x16x32_bf16(Bt[n][k], At[m][k], acc[ai][bj][m][n], 0, 0, 0); __builtin_amdgcn_s_setprio(0); } while (0)
#define PG8_WAIT_V(n) asm volatile("s_waitcnt vmcnt(" #n ")" ::: "memory")
#define PG8_WAIT_L(n) asm volatile("s_waitcnt lgkmcnt(" #n ")" ::: "memory")
#define PG8_BAR __builtin_amdgcn_s_barrier()
#define PG8_SCHED __builtin_amdgcn_sched_barrier(0)
    Unit cur, nxt; int ui = 0;
    if (!S.next(0, cur)) return;
    f32x4 acc[2][2][4][2];
#pragma unroll
    for (int a = 0; a < 2; ++a)
#pragma unroll
        for (int b = 0; b < 2; ++b)
#pragma unroll
            for (int m = 0; m < 4; ++m)
#pragma unroll
                for (int n = 0; n < 2; ++n) acc[a][b][m][n] = (f32x4){0.f, 0.f, 0.f, 0.f};
    bf16x8 At[4][2], B0[2][2], B1[2][2];
    const char* cA = S.abase(g, cur); const char* cB = S.bbase(g, cur);
    PG8_STAGE(PG8_SB(0, 0), cB, voffB); PG8_STAGE(PG8_SA(0, 0), cA, voffA); PG8_STAGE(PG8_SB(0, 1), cB + hstep, voffB); PG8_STAGE(PG8_SA(0, 1), cA + hstep, voffA);
    if (wr == 1) PG8_BAR;
    PG8_WAIT_V(4); PG8_BAR;
    PG8_STAGE(PG8_SB(1, 0), cB + kstep, voffB); PG8_STAGE(PG8_SA(1, 0), cA + kstep, voffA); PG8_STAGE(PG8_SB(1, 1), cB + hstep + kstep, voffB);
    PG8_WAIT_V(6); PG8_BAR;
    for (;;) {
        const bool has_next = S.next(ui + 1, nxt);
        const char* nA = has_next ? S.abase(g, nxt) : cA; const char* nB = has_next ? S.bbase(g, nxt) : cB;
        for (int t = 0; t < nt; t += 2) {
            const bool last = (t == nt - 2);
            const char* a1 = cA + (size_t)(t + 1) * kstep;
            const char* a2 = last ? nA : cA + (size_t)(t + 2) * kstep; const char* b2 = last ? nB : cB + (size_t)(t + 2) * kstep;
            const char* a3 = a2 + kstep; const char* b3 = b2 + kstep;
            PG8_LDB(B0, 0, 0); PG8_SCHED; PG8_LDA(At, 0, 0); PG8_STAGE(PG8_SA(1, 1), a1 + hstep, voffA);
            PG8_WAIT_L(8); PG8_BAR; PG8_WAIT_L(0); PG8_MMA(0, 0, At, B0); PG8_BAR; PG8_SCHED;
            PG8_LDB(B1, 0, 1); PG8_STAGE(PG8_SB(0, 0), b2, voffB);
            PG8_BAR; PG8_WAIT_L(0); PG8_MMA(0, 1, At, B1); PG8_BAR;
            PG8_LDA(At, 0, 1); PG8_STAGE(PG8_SA(0, 0), a2, voffA);
            PG8_BAR; PG8_WAIT_L(0); PG8_MMA(1, 0, At, B0); PG8_BAR; PG8_SCHED;
            PG8_STAGE(PG8_SB(0, 1), b2 + hstep, voffB);
            PG8_WAIT_V(6); PG8_BAR; PG8_MMA(1, 1, At, B1); PG8_BAR;
            PG8_LDB(B0, 1, 0); PG8_SCHED; PG8_LDA(At, 1, 0); PG8_STAGE(PG8_SA(0, 1), a2 + hstep, voffA);
            PG8_WAIT_L(8); PG8_BAR; PG8_WAIT_L(0); PG8_MMA(0, 0, At, B0); PG8_BAR; PG8_SCHED;
            PG8_LDB(B1, 1, 1); PG8_STAGE(PG8_SB(1, 0), b3, voffB);
            PG8_BAR; PG8_WAIT_L(0); PG8_MMA(0, 1, At, B1); PG8_BAR;
            PG8_LDA(At, 1, 1); PG8_STAGE(PG8_SA(1, 0), a3, voffA);
            PG8_BAR; PG8_WAIT_L(0); PG8_MMA(1, 0, At, B0); PG8_BAR; PG8_SCHED;
            PG8_STAGE(PG8_SB(1, 1), b3 + hstep, voffB);
            PG8_WAIT_V(6); PG8_BAR; PG8_MMA(1, 1, At, B1); PG8_BAR;
        }
#pragma unroll
        for (int ai = 0; ai < 2; ++ai) {
            if constexpr (Epi::PAIR) {
                typename Epi::Pre pre[2];
#pragma unroll
                for (int bj = 0; bj < 2; ++bj) E.template prefetch<4>(pre[bj], (cur.pm * 2 + ai) * 128 + wr * 64, cur.pn * 2 + bj, wc, lane);
#pragma unroll
                for (int bj = 0; bj < 2; ++bj) E.template apply<4>(acc[ai][bj], pre[bj], (cur.pm * 2 + ai) * 128 + wr * 64, cur.pn * 2 + bj, wc, lane);
            } else {
#pragma unroll
                for (int bj = 0; bj < 2; ++bj) {
                    typename Epi::Pre pre;
                    E.template prefetch<4>(pre, (cur.pm * 2 + ai) * 128 + wr * 64, cur.pn * 2 + bj, wc, lane);
                    E.template apply<4>(acc[ai][bj], pre, (cur.pm * 2 + ai) * 128 + wr * 64, cur.pn * 2 + bj, wc, lane);
                }
            }
        }
        if (!has_next) break;
#pragma unroll
        for (int a = 0; a < 2; ++a)
#pragma unroll
            for (int b = 0; b < 2; ++b)
#pragma unroll
                for (int m = 0; m < 4; ++m)
#pragma unroll
                    for (int n = 0; n < 2; ++n) acc[a][b][m][n] = (f32x4){0.f, 0.f, 0.f, 0.f};
        cur = nxt; cA = nA; cB = nB; ++ui;
    }
    PG8_WAIT_V(0);
    if (wr == 0) PG8_BAR;
    PG8_BAR;
#undef PG8_SA
#undef PG8_SB
#undef PG8_STAGE
#undef PG8_LDA
#undef PG8_LDB
#undef PG8_MMA
#undef PG8_WAIT_V
#undef PG8_WAIT_L
#undef PG8_BAR
#undef PG8_SCHED
}
}

template <class LA, class LB>
__device__ __forceinline__ void mma_tile_dma(f32x4 (&acc)[4][2], const LA& la, const LB& lb, const int K, LAS unsigned char* lds) {
    using pg8::HTB; using pg8::lds_byte; using pg8::stage_rc;
    const int tid = tid_opaque(), lane = tid & 63, wid = __builtin_amdgcn_readfirstlane(tid >> 6), wm = wid >> 2, wn = wid & 3, fr = lane & 15, fq = lane >> 4;
    const int nkt = K >> 6;
    int sR[2], sC[2];
#pragma unroll
    for (int i = 0; i < 2; ++i) stage_rc(tid * 16 + i * 8192, sR[i], sC[i]);
    const unsigned ldsw = (unsigned)wid * 1024u;
    const int aoff = lds_byte(wm * 64 + fr, fq * 8), boff = lds_byte(wn * 32 + fr, fq * 8);
#define TD_STAGE(kt_) do { const int _s = (kt_) & 3; _Pragma("unroll") for (int _i = 0; _i < 2; ++_i) { \
        __builtin_amdgcn_global_load_lds((const unsigned*)la(sR[_i], (kt_) * 64 + sC[_i]), (LAS unsigned*)(lds + _s * 2 * HTB + ldsw + _i * 8192), 16, 0, 0); \
        __builtin_amdgcn_global_load_lds((const unsigned*)lb(sR[_i], (kt_) * 64 + sC[_i]), (LAS unsigned*)(lds + _s * 2 * HTB + HTB + ldsw + _i * 8192), 16, 0, 0); } } while (0)
    TD_STAGE(0);
    if (nkt > 1) TD_STAGE(1);
    if (nkt > 2) TD_STAGE(2);
    for (int kt = 0; kt < nkt; ++kt) {
        const int ahead = nkt - 1 - kt;
        if (ahead >= 2) asm volatile("s_waitcnt vmcnt(8)" ::: "memory");
        else if (ahead == 1) asm volatile("s_waitcnt vmcnt(4)" ::: "memory");
        else asm volatile("s_waitcnt vmcnt(0)" ::: "memory");
        __builtin_amdgcn_s_barrier();
        asm volatile("" ::: "memory");
        if (kt + 3 < nkt) TD_STAGE(kt + 3);
        const LAS unsigned char* Ab = lds + (kt & 3) * 2 * HTB; const LAS unsigned char* Bb = Ab + HTB;
#pragma unroll
        for (int ks = 0; ks < 2; ++ks) {
            bf16x8 af[4], bfr[2];
#pragma unroll
            for (int mt = 0; mt < 4; ++mt) af[mt] = *(const LAS bf16x8*)(Ab + aoff + mt * 2048 + ks * 1024);
#pragma unroll
            for (int nt = 0; nt < 2; ++nt) bfr[nt] = *(const LAS bf16x8*)(Bb + boff + nt * 2048 + ks * 1024);
#pragma unroll
            for (int mt = 0; mt < 4; ++mt)
#pragma unroll
                for (int nt = 0; nt < 2; ++nt) acc[mt][nt] = __builtin_amdgcn_mfma_f32_16x16x32_bf16(bfr[nt], af[mt], acc[mt][nt], 0, 0, 0);
        }
    }
    asm volatile("s_waitcnt lgkmcnt(0)" ::: "memory");
    __builtin_amdgcn_s_barrier();
    asm volatile("" ::: "memory");
#undef TD_STAGE
}

template <int NKT, class IdFn, class LdFn, class EpFn>
__device__ __forceinline__ void tile_stream(const int nloc, const IdFn& idf, const LdFn& ldf, const EpFn& epf, LAS unsigned char* lds) {
    using pg8::HTB; using pg8::lds_byte; using pg8::stage_rc;
    const int tid = tid_opaque(), lane = tid & 63, wid = __builtin_amdgcn_readfirstlane(tid >> 6), wm = wid >> 2, wn = wid & 3, fr = lane & 15, fq = lane >> 4;
    if (nloc <= 0) return;
    const int total = nloc * NKT;
    int sR[2], sC[2];
#pragma unroll
    for (int i = 0; i < 2; ++i) stage_rc(tid * 16 + i * 8192, sR[i], sC[i]);
    const unsigned ldsw = (unsigned)wid * 1024u;
    const int aoff = lds_byte(wm * 64 + fr, fq * 8), boff = lds_byte(wn * 32 + fr, fq * 8);
#define TS_STAGE(j_) do { const int _j = (j_), _t = _j / NKT, _kt = _j - _t * NKT, _s = _j & 3; const int _id = idf(_t); _Pragma("unroll") for (int _i = 0; _i < 2; ++_i) { \
        const bf16_t* _pa; const bf16_t* _pb; ldf(_id, sR[_i], _kt * 64 + sC[_i], _pa, _pb); \
        __builtin_amdgcn_global_load_lds((const unsigned*)_pa, (LAS unsigned*)(lds + _s * 2 * HTB + ldsw + _i * 8192), 16, 0, 0); \
        __builtin_amdgcn_global_load_lds((const unsigned*)_pb, (LAS unsigned*)(lds + _s * 2 * HTB + HTB + ldsw + _i * 8192), 16, 0, 0); } } while (0)
    TS_STAGE(0);
    if (total > 1) TS_STAGE(1);
    if (total > 2) TS_STAGE(2);
    f32x4 acc[4][2]; zero_acc(acc);
    int kt = 0, tl = 0;
#pragma unroll 1
    for (int j = 0; j < total; ++j) {
        const int ahead = total - 1 - j;
        if (ahead >= 2) asm volatile("s_waitcnt vmcnt(8)" ::: "memory");
        else if (ahead == 1) asm volatile("s_waitcnt vmcnt(4)" ::: "memory");
        else asm volatile("s_waitcnt vmcnt(0)" ::: "memory");
        __builtin_amdgcn_s_barrier();
        asm volatile("" ::: "memory");
        if (j + 3 < total) TS_STAGE(j + 3);
        const LAS unsigned char* Ab = lds + (j & 3) * 2 * HTB; const LAS unsigned char* Bb = Ab + HTB;
#pragma unroll
        for (int ks = 0; ks < 2; ++ks) {
            bf16x8 af[4], bfr[2];
#pragma unroll
            for (int mt = 0; mt < 4; ++mt) af[mt] = *(const LAS bf16x8*)(Ab + aoff + mt * 2048 + ks * 1024);
#pragma unroll
            for (int nt = 0; nt < 2; ++nt) bfr[nt] = *(const LAS bf16x8*)(Bb + boff + nt * 2048 + ks * 1024);
#pragma unroll
            for (int mt = 0; mt < 4; ++mt)
#pragma unroll
                for (int nt = 0; nt < 2; ++nt) acc[mt][nt] = __builtin_amdgcn_mfma_f32_16x16x32_bf16(bfr[nt], af[mt], acc[mt][nt], 0, 0, 0);
        }
        if (++kt == NKT) { epf(idf(tl), acc, wm, wn, lane); zero_acc(acc); kt = 0; ++tl; }
    }
    asm volatile("s_waitcnt lgkmcnt(0)" ::: "memory");
    __builtin_amdgcn_s_barrier();
    asm volatile("" ::: "memory");
#undef TS_STAGE
}

__device__ __forceinline__ void phase_modv(const Ctx& p, LAS unsigned char* lds) {
    LAS float* sl = (LAS float*)lds;
    LAS float* part = sl + 3 * 1024;
    const int tid = threadIdx.x;
    for (int i = tid; i < 3 * 1024; i += NT) {
        const int mi = i >> 10, k = i & 1023;
        const float v = mi < 2 ? p.in(I_C)[mi * 1024 + k] : p.in(I_CCTX)[k];
        sl[i] = silu_f(v);
    }
    __syncthreads();
    float* modv = (float*)(p.ws() + OFF_MODV);
    for (int u = blockIdx.x; u < 4 * 96; u += gridDim.x) {
        const int l = u / 96, cb = u % 96, col = cb * 64 + (tid & 63), kp = tid >> 6;
        const float* w = p.in(I_WMOD) + (size_t)l * 1024 * 6144 + col;
        float a0 = 0.f, a1 = 0.f, a2 = 0.f;
#pragma unroll 32
        for (int k = kp * 128; k < kp * 128 + 128; ++k) {
            const float wv = w[(size_t)k * 6144];
            a0 += sl[k] * wv; a1 += sl[1024 + k] * wv; a2 += sl[2048 + k] * wv;
        }
        part[(kp * 3 + 0) * 64 + (tid & 63)] = a0; part[(kp * 3 + 1) * 64 + (tid & 63)] = a1; part[(kp * 3 + 2) * 64 + (tid & 63)] = a2;
        __syncthreads();
        if (tid < 192) {
            const int mi = tid >> 6, c = tid & 63;
            float s = p.in(I_BMOD)[l * 6144 + cb * 64 + c];
#pragma unroll
            for (int q = 0; q < 8; ++q) s += part[(q * 3 + mi) * 64 + c];
            modv[((size_t)l * 3 + mi) * 6144 + cb * 64 + c] = s;
        }
        __syncthreads();
    }
    if (blockIdx.x == gridDim.x - 1) {
        float* rope = (float*)(p.ws() + OFF_ROPE);
        for (int i = tid; i < 320 * 32; i += NT) {
            const int pos = i >> 5, j = i & 31;
            const float fr = powf(10000.f, -(float)j / 32.f);
            const float posf = pos < 256 ? (float)pos : (float)(pos - 256);
            float s, c; sincosf(posf * fr, &s, &c);
            if (pos < 256) { rope[pos * 32 + j] = c; rope[8192 + pos * 32 + j] = s; }
            else { rope[16384 + (pos - 256) * 32 + j] = c; rope[16384 + 2048 + (pos - 256) * 32 + j] = s; }
        }
    }
}

template <class F>
__device__ __forceinline__ void transpose_unit(bf16_t* __restrict__ dst, const float* __restrict__ src, int ldsrc, int K, int n0, int k0, F srccol) {
    const int tid_ = tid_opaque(), n = n0 + (tid_ & 63), kb = tid_ >> 6, sc = srccol(n);
#pragma unroll
    for (int kk = 0; kk < 8; ++kk) {
        const int k = k0 + kb * 64 + kk * 8;
        float v[8];
#pragma unroll
        for (int i = 0; i < 8; ++i) v[i] = src[(size_t)(k + i) * ldsrc + sc];
        uint4 o; o.x = pack_bf16(v[0], v[1]); o.y = pack_bf16(v[2], v[3]); o.z = pack_bf16(v[4], v[5]); o.w = pack_bf16(v[6], v[7]);
        *(uint4*)(dst + (size_t)n * K + k) = o;
    }
}
__device__ __forceinline__ int rope_perm(int n) {
    const int wn = n >> 5, half = (n >> 4) & 1, i = n & 15;
    return (wn >> 1) * 64 + half * 32 + (wn & 1) * 16 + i;
}
__device__ __forceinline__ void convert_unit(bf16_t* __restrict__ dst, const float* __restrict__ src, size_t e0) {
#pragma unroll
    for (int it = 0; it < 8; ++it) {
        const size_t e = e0 + (size_t)(it * NT + tid_opaque()) * 8;
        const float4 a = *(const float4*)(src + e), b = *(const float4*)(src + e + 4);
        uint4 o; o.x = pack_bf16(a.x, a.y); o.y = pack_bf16(a.z, a.w); o.z = pack_bf16(b.x, b.y); o.w = pack_bf16(b.z, b.w);
        *(uint4*)(dst + e) = o;
    }
}
__device__ __forceinline__ void s5_prep_group(const Ctx& p, int l, int g, int q4, LAS unsigned char* lds);
__device__ __forceinline__ void fp8_rows_unit(unsigned char* __restrict__ dst, float* __restrict__ sinv, const float* __restrict__ src, int row0) {
    const int tid = tid_opaque(), lane = tid & 63, wid = tid >> 6;
#pragma unroll
    for (int rr = 0; rr < 4; ++rr) {
        const int row = row0 + wid * 4 + rr;
        const float* sp = src + (size_t)row * D + lane * 16;
        float4 v[4]; float amax = 0.f;
#pragma unroll
        for (int i = 0; i < 4; ++i) { v[i] = *(const float4*)(sp + i * 4); amax = fmaxf(amax, fmaxf(fmaxf(fabsf(v[i].x), fabsf(v[i].y)), fmaxf(fabsf(v[i].z), fabsf(v[i].w)))); }
#pragma unroll
        for (int o = 32; o > 0; o >>= 1) amax = fmaxf(amax, __shfl_xor(amax, o));
        int e = (int)((__float_as_uint(amax) >> 23) & 0xFFu) - 127;
        e = e < -100 ? -100 : (e > 100 ? 100 : e);
        const float sc = __uint_as_float((unsigned)(127 + 7 - e) << 23), inv = __uint_as_float((unsigned)(127 - 7 + e) << 23);
        u32x4 o4;
#pragma unroll
        for (int i = 0; i < 4; ++i) {
            int w = __builtin_amdgcn_cvt_pk_fp8_f32(v[i].x * sc, v[i].y * sc, 0, false);
            w = __builtin_amdgcn_cvt_pk_fp8_f32(v[i].z * sc, v[i].w * sc, w, true);
            o4[i] = (unsigned)w;
        }
        *(u32x4*)(dst + (size_t)row * D + lane * 16) = o4;
        if (lane == 0) sinv[row] = inv;
    }
}
__device__ __forceinline__ void phase_prep(const Ctx& p, int l, int rot, LAS unsigned char* lds) {
    constexpr int U_S5 = 128, U_WIN = 144, U_GLU = 32, U_RU = 16, U_OUT = 32, U_WQ = 32, U_PU = 512, U_PV = 512, U_SK = 4;
    constexpr int B_WIN = U_S5, B_GLU = B_WIN + U_WIN, B_RU = B_GLU + U_GLU, B_OUT = B_RU + U_RU, B_WQ = B_OUT + U_OUT, B_PU = B_WQ + U_WQ,
                  B_PV = B_PU + U_PU, B_SK = B_PV + U_PV, NU = B_SK + U_SK;
    for (int u = (blockIdx.x + rot) % gridDim.x; u < NU; u += gridDim.x) {
        if (u < B_WIN) {
            s5_prep_group(p, l, u >> 2, u & 3, lds);
        } else if (u < B_GLU) {
            const int v = u - B_WIN;
            transpose_unit((bf16_t*)(wsw(p, l) + OFF_WINT), p.in(I_WIN) + (size_t)l * D * INC, INC, D, (v >> 1) * 64, (v & 1) * 512,
                           [](int n) { return (n >= 512 && n < 1536) ? 512 + ((n - 512) >> 7) * 128 + rope_perm((n - 512) & 127) : n; });
        } else if (u < B_RU) {
            const int v = u - B_GLU;
            transpose_unit((bf16_t*)(wsw(p, l) + OFF_WGLUT), p.in(I_WGLU) + (size_t)l * 512 * 2048, 2048, 512, v * 64, 0,
                           [](int n) { const int ntile = n >> 7, q = n & 127; return ((q >> 4) & 1) * 1024 + ntile * 64 + (q >> 5) * 16 + (q & 15); });
        } else if (u < B_OUT) {
            const int v = u - B_RU;
            transpose_unit((bf16_t*)(wsw(p, l) + OFF_WRUT), p.in(I_WRU) + (size_t)l * 512 * 1024, 1024, 512, v * 64, 0, [](int n) { return n; });
        } else if (u < B_WQ) {
            const int v = u - B_OUT;
            transpose_unit((bf16_t*)(wsw(p, l) + OFF_WOUTT), p.in(I_WOUT) + (size_t)l * D * D, D, D, (v >> 1) * 64, (v & 1) * 512, [](int n) { return n; });
        } else if (u < B_PU) {
            const int v = u - B_WQ;
            transpose_unit((bf16_t*)(wsw(p, l) + OFF_WQT), p.in(I_WQ) + (size_t)l * D * D, D, D, (v >> 1) * 64, (v & 1) * 512, [](int n) { return n; });
        } else if (u < B_PV) {
            fp8_rows_unit(wsw(p, l) + OFF_PU, (float*)(wsw(p, l) + OFF_SCU), p.in(I_PU) + (size_t)l * NEXP * D, (u - B_PU) * 32);
        } else if (u < B_SK) {
            fp8_rows_unit(wsw(p, l) + OFF_PV, (float*)(wsw(p, l) + OFF_SCV), p.in(I_PV) + (size_t)l * NEXP * D, (u - B_PV) * 32);
        } else {
            convert_unit((bf16_t*)(wsw(p, l) + OFF_SKEY), p.in(I_SKEY) + (size_t)l * 16 * 128 * 64, (size_t)(u - B_SK) * 32768);
        }
    }
}

__device__ __forceinline__ const float* x_row_ptr(const Ctx& p, int l, int which, int row) {
    if (row < ML) return (l == 0 && which == 0) ? p.in(I_X) + (size_t)row * D : p.out() + (size_t)row * D;
    return (l == 0 && which == 0) ? p.in(I_CTX) + (size_t)(row - ML) * D : (const float*)(p.ws() + OFF_XC) + (size_t)(row - ML) * D;
}
__device__ __forceinline__ void phase_norm(const Ctx& p, int l, int which) {
    const int tid = tid_opaque(), lane = tid & 63, wid = __builtin_amdgcn_readfirstlane(tid >> 6);
    const float* gain = p.in(which == 0 ? I_N1G : I_N2G) + l * D;
    const float* modv = (const float*)(p.ws() + OFF_MODV) + (size_t)l * 3 * 6144;
    bf16_t* H = (bf16_t*)(p.ws() + OFF_H);
    const int nw = gridDim.x * 8, gw = blockIdx.x * 8 + wid;
    const int mrows = (which == 1 && l == DEPTH - 1) ? ML : M;
#pragma unroll 1
    for (int row0 = gw; row0 < mrows; row0 += 2 * nw) {
        const int row1 = row0 + nw; const bool has1 = row1 < mrows;
        const float* xr0 = x_row_ptr(p, l, which, row0); const float* xr1 = x_row_ptr(p, l, which, has1 ? row1 : row0);
        const float* mv0 = modv + (size_t)mod_index(row0) * 6144 + which * 3072; const float* mv1 = modv + (size_t)mod_index(has1 ? row1 : row0) * 6144 + which * 3072;
        float4 v0[4], v1[4], g[4], sh0[4], sc0[4], sh1[4], sc1[4];
#pragma unroll
        for (int i = 0; i < 4; ++i) {
            const int c = i * 256 + lane * 4;
            v0[i] = *(const float4*)(xr0 + c); v1[i] = *(const float4*)(xr1 + c); g[i] = *(const float4*)(gain + c);
            sh0[i] = *(const float4*)(mv0 + c); sc0[i] = *(const float4*)(mv0 + 1024 + c); sh1[i] = *(const float4*)(mv1 + c); sc1[i] = *(const float4*)(mv1 + 1024 + c);
        }
        float ss0 = 0.f, ss1 = 0.f;
#pragma unroll
        for (int i = 0; i < 4; ++i) {
            ss0 += v0[i].x * v0[i].x + v0[i].y * v0[i].y + v0[i].z * v0[i].z + v0[i].w * v0[i].w;
            ss1 += v1[i].x * v1[i].x + v1[i].y * v1[i].y + v1[i].z * v1[i].z + v1[i].w * v1[i].w;
        }
        ss0 = wave_sum(ss0); ss1 = wave_sum(ss1);
        const float r0 = rsqrtf(ss0 * (1.f / 1024.f) + EPS), r1 = rsqrtf(ss1 * (1.f / 1024.f) + EPS);
#pragma unroll
        for (int i = 0; i < 4; ++i) {
            const int c = i * 256 + lane * 4;
            uint2 o; o.x = pack_bf16(v0[i].x * r0 * g[i].x * (1.f + sc0[i].x) + sh0[i].x, v0[i].y * r0 * g[i].y * (1.f + sc0[i].y) + sh0[i].y);
            o.y = pack_bf16(v0[i].z * r0 * g[i].z * (1.f + sc0[i].z) + sh0[i].z, v0[i].w * r0 * g[i].w * (1.f + sc0[i].w) + sh0[i].w);
            *(uint2*)(H + (size_t)row0 * D + c) = o;
        }
        if (has1) {
#pragma unroll
            for (int i = 0; i < 4; ++i) {
                const int c = i * 256 + lane * 4;
                uint2 o; o.x = pack_bf16(v1[i].x * r1 * g[i].x * (1.f + sc1[i].x) + sh1[i].x, v1[i].y * r1 * g[i].y * (1.f + sc1[i].y) + sh1[i].y);
                o.y = pack_bf16(v1[i].z * r1 * g[i].z * (1.f + sc1[i].z) + sh1[i].z, v1[i].w * r1 * g[i].w * (1.f + sc1[i].w) + sh1[i].w);
                *(uint2*)(H + (size_t)row1 * D + c) = o;
            }
        }
    }
}

struct RowInfo { int b, ts, t; bool lat; };
__device__ __forceinline__ RowInfo row_info(int row) {
    RowInfo r;
    if (row < ML) { r.b = row >> 14; r.t = row & 16383; r.ts = r.t; r.lat = true; }
    else { const int rc = row - ML; r.b = rc >> 8; r.t = rc & 255; r.ts = SEQ + r.t; r.lat = false; }
    return r;
}
__device__ __forceinline__ void store_bf16x4(bf16_t* dst, float a, float b, float c, float d) {
    uint2 o; o.x = pack_bf16(a, b); o.y = pack_bf16(c, d); *(uint2*)dst = o;
}
__device__ __forceinline__ unsigned short f2bf(float f) { return (unsigned short)(pack_bf16(f, 0.f) & 0xFFFFu); }
__device__ __forceinline__ int s5_rowbase(int R) {
    const int b = R / 520, cs = R - b * 520;
    return cs < 512 ? b * SEQ + cs * 32 : ML + b * CTX + (cs - 512) * 32;
}

__device__ __forceinline__ int s5_chunkrow(int row) {
    return row < ML ? (row >> 14) * 520 + ((row & 16383) >> 5) : ((row - ML) >> 8) * 520 + 512 + (((row - ML) & 255) >> 5);
}

__device__ __forceinline__ void s5_prep_group(const Ctx& p, int l, int g, int q4, LAS unsigned char* lds) {
    LAS float* powf = (LAS float*)lds;
    LAS float* powb = powf + 4224;
    LAS float* Gf = powb + 4224;
    LAS float* Gb = Gf + 2048;
    LAS float* Cc = Gb + 2048;
    LAS float* Kt = Cc + 2048;
    const int tid = tid_opaque();
    const int lg = l * 32 + g;
    for (int e = tid; e < 2 * 33 * 64; e += NT) {
        const int dir = e / (33 * 64), k = (e / 64) % 33, pp = e & 63;
        const float lre = p.in(dir ? I_LREB : I_LREF)[lg * 64 + pp], lim = p.in(dir ? I_LIMB : I_LIMF)[lg * 64 + pp];
        const float dt = expf(p.in(dir ? I_LDTB : I_LDTF)[lg]);
        const float mag = expf((float)k * lre * dt);
        float sn, cs; sincosf((float)k * lim * dt, &sn, &cs);
        LAS float* pw = dir ? powb : powf;
        pw[(k * 64 + pp) * 2] = mag * cs; pw[(k * 64 + pp) * 2 + 1] = mag * sn;
    }
    for (int e = tid; e < 2 * 64 * 16; e += NT) {
        const int dir = e >> 10, pp = (e >> 4) & 63, j = e & 15;
        const float lre = p.in(dir ? I_LREB : I_LREF)[lg * 64 + pp], lim = p.in(dir ? I_LIMB : I_LIMF)[lg * 64 + pp];
        const float dt = expf(p.in(dir ? I_LDTB : I_LDTF)[lg]);
        const float mag = expf(lre * dt);
        float sn, cs; sincosf(lim * dt, &sn, &cs);
        const float nr = mag * cs - 1.f, ni = mag * sn, den = lre * lre + lim * lim;
        const float br = (nr * lre + ni * lim) / den, bi = (ni * lre - nr * lim) / den;
        const float Br = p.in(I_BRE)[(lg * 64 + pp) * 16 + j], Bi = p.in(I_BIM)[(lg * 64 + pp) * 16 + j];
        LAS float* G = dir ? Gb : Gf;
        G[(pp * 16 + j) * 2] = br * Br - bi * Bi; G[(pp * 16 + j) * 2 + 1] = br * Bi + bi * Br;
    }
    for (int e = tid; e < 16 * 64; e += NT) {
        Cc[e * 2] = p.in(I_CRE)[lg * 1024 + e]; Cc[e * 2 + 1] = p.in(I_CIM)[lg * 1024 + e];
    }
    __syncthreads();
    for (int e0 = tid; e0 < 63 * 64; e0 += NT) {
        const int idx = e0 >> 6, i = 4 * q4 + ((e0 >> 4) & 3), j = e0 & 15, e = (idx * 16 + i) * 16 + j;
        float acc = 0.f;
        if (idx >= 31) {
            const int lag = idx - 31;
            for (int pp = 0; pp < 64; ++pp) {
                const float cr = Cc[(i * 64 + pp) * 2], ci = Cc[(i * 64 + pp) * 2 + 1], ar = powf[(lag * 64 + pp) * 2], ai = powf[(lag * 64 + pp) * 2 + 1];
                const float zr = cr * ar - ci * ai, zi = cr * ai + ci * ar;
                acc += zr * Gf[(pp * 16 + j) * 2] - zi * Gf[(pp * 16 + j) * 2 + 1];
            }
        }
        if (idx <= 31) {
            const int lag = 31 - idx;
            for (int pp = 0; pp < 64; ++pp) {
                const float cr = Cc[(i * 64 + pp) * 2], ci = Cc[(i * 64 + pp) * 2 + 1], ar = powb[(lag * 64 + pp) * 2], ai = powb[(lag * 64 + pp) * 2 + 1];
                const float zr = cr * ar - ci * ai, zi = cr * ai + ci * ar;
                acc += zr * Gb[(pp * 16 + j) * 2] - zi * Gb[(pp * 16 + j) * 2 + 1];
            }
        }
        if (idx == 31 && i == j) acc += p.in(I_SSMD)[l * 512 + g * 16 + i];
        Kt[e] = acc;
    }
    __syncthreads();
    bf16_t* TV = (bf16_t*)(wsw(p, l) + OFF_S5TV) + (size_t)g * 512 * 768;
    for (int piece = tid; piece < 128 * 96; piece += NT) {
        const int nq = piece / 96, k0 = (piece - nq * 96) * 8, t = nq >> 2, i = 4 * q4 + (nq & 3), n = t * 16 + i;
        float v[8];
        if (k0 < 512) {
            const int s_ = k0 >> 4, j0 = k0 & 15;
#pragma unroll
            for (int q = 0; q < 8; ++q) v[q] = Kt[((31 + t - s_) * 16 + i) * 16 + j0 + q];
        } else {
            const int kk = k0 - 512, comp = kk >> 6, p0 = kk & 63, dir = comp >> 1;
            const LAS float* pw = dir ? powb + (32 - t) * 128 : powf + (t + 1) * 128;
#pragma unroll
            for (int q = 0; q < 8; ++q) {
                const int pp = p0 + q;
                const float cr = Cc[(i * 64 + pp) * 2], ci = Cc[(i * 64 + pp) * 2 + 1], ar = pw[pp * 2], ai = pw[pp * 2 + 1];
                v[q] = (comp & 1) ? -(cr * ai + ci * ar) : (cr * ar - ci * ai);
            }
        }
        uint4 o; o.x = pack_bf16(v[0], v[1]); o.y = pack_bf16(v[2], v[3]); o.z = pack_bf16(v[4], v[5]); o.w = pack_bf16(v[6], v[7]);
        *(uint4*)(TV + (size_t)n * 768 + k0) = o;
    }
    bf16_t* W = (bf16_t*)(wsw(p, l) + OFF_S5W) + (size_t)g * 256 * 512;
    for (int piece = tid; piece < 64 * 64; piece += NT) {
        const int n = 64 * q4 + (piece >> 6), k0 = (piece & 63) * 8, comp = n >> 6, pp = n & 63, s_ = k0 >> 4, j0 = k0 & 15, dir = comp >> 1;
        const LAS float* pw = dir ? powb + (s_ * 64 + pp) * 2 : powf + ((31 - s_) * 64 + pp) * 2;
        const LAS float* G = (dir ? Gb : Gf) + (pp * 16 + j0) * 2;
        const float ar = pw[0], ai = pw[1];
        float v[8];
#pragma unroll
        for (int q = 0; q < 8; ++q) { const float gr = G[q * 2], gi = G[q * 2 + 1]; v[q] = (comp & 1) ? (ar * gi + ai * gr) : (ar * gr - ai * gi); }
        uint4 o; o.x = pack_bf16(v[0], v[1]); o.y = pack_bf16(v[2], v[3]); o.z = pack_bf16(v[4], v[5]); o.w = pack_bf16(v[6], v[7]);
        *(uint4*)(W + (size_t)n * 512 + k0) = o;
    }
    if (tid < 128 && q4 == 0) {
        const int dir = tid >> 6, pp = tid & 63;
        float* AT = (float*)(wsw(p, l) + OFF_S5AT) + ((g * 2 + dir) * 64 + pp) * 2;
        const LAS float* pw = (dir ? powb : powf) + (32 * 64 + pp) * 2;
        AT[0] = pw[0]; AT[1] = pw[1];
    }
    __syncthreads();
}

template <bool SW, class Epi>
__device__ __forceinline__ void thin_ctx_gemm(const bf16_t* A, const bf16_t* Bt, const int K, const int nt_lo, const int nt_hi, const Epi& E, LAS unsigned char* lds) {
    static_assert(SW, "swapped accumulator layout only");
    const int tid = tid_opaque(), lane = tid & 63, wid = __builtin_amdgcn_readfirstlane(tid >> 6), wm = wid >> 2, wn = wid & 3;
    const int ntile = 4 * (nt_hi - nt_lo);
#pragma unroll 1
    for (int t = blockIdx.x; t < ntile; t += gridDim.x) {
        const int mt = t & 3, nt = nt_lo + (t >> 2);
        const bf16_t* Ab = A + (size_t)(ML + mt * 128) * K; const bf16_t* Bb = Bt + (size_t)nt * 128 * K;
        f32x4 acc[4][2]; zero_acc(acc);
        mma_tile_dma(acc, [=](int r, int k) { return Ab + (size_t)r * K + k; }, [=](int r, int k) { return Bb + (size_t)r * K + k; }, K, lds);
        typename Epi::Pre pre;
        E.template prefetch<4>(pre, ML + mt * 128 + wm * 64, nt, wn, lane);
        E.template apply<4>(acc, pre, ML + mt * 128 + wm * 64, nt, wn, lane);
    }
}

struct EpiG1 {
    const Ctx& p; int l;
    template <int NA>
    __device__ __forceinline__ void operator()(const f32x4 (&acc)[NA][2], int rowbase, int nt, int wn, int lane_) const {
        int lane = lane_; asm volatile("" : "+v"(lane));
        const float* rope = (const float*)(p.ws() + OFF_ROPE);
        const int fq = lane >> 4;
        if (nt < 8 || nt >= 16) {
            bf16_t* dst; int ld, c0; bool isq = false;
            if (nt < 4) { dst = (bf16_t*)(p.ws() + OFF_U); ld = 512; c0 = nt * 128; }
            else if (nt < 8) { dst = (bf16_t*)(p.ws() + OFF_Q); ld = 512; c0 = (nt - 4) * 128; isq = true; }
            else if (nt < 20) { dst = (bf16_t*)(p.ws() + OFF_G); ld = 512; c0 = (nt - 16) * 128; }
            else if (nt < 28) { dst = (bf16_t*)(p.ws() + OFF_GS); ld = 1024; c0 = (nt - 20) * 128; }
            else { dst = (bf16_t*)(p.ws() + OFF_GR); ld = 1024; c0 = (nt - 28) * 128; }
            f32x4 rc[NA], rs[NA];
            if (isq) {
#pragma unroll
                for (int a = 0; a < NA; ++a) {
                    const int row = rowbase + a * 16 + (lane & 15);
                    const int t = row & 16383, sec = wn >> 1, pos = (row < ML) ? (sec ? (t & 63) : (t >> 6)) : 0;
                    const float* cs = rope + (sec ? 16384 : 0) + pos * 32 + (wn & 1) * 16 + 4 * fq;
                    rc[a] = *(const f32x4*)cs; rs[a] = *(const f32x4*)(cs + (sec ? 2048 : 8192));
                }
            }
#pragma unroll
            for (int a = 0; a < NA; ++a) {
                const int row = rowbase + a * 16 + (lane & 15);
                f32x4 v0 = acc[a][0], v1 = acc[a][1];
                if (isq && row < ML) {
#pragma unroll
                    for (int r = 0; r < 4; ++r) { const float c = rc[a][r], s_ = rs[a][r], t1 = v0[r], t2 = v1[r]; v0[r] = t1 * c - t2 * s_; v1[r] = t1 * s_ + t2 * c; }
                }
                {
                    bf16_t* rp = nt < 4 ? (bf16_t*)(p.ws() + OFF_AS5) + ((size_t)(nt * 8 + wn * 2) * 1040 + s5_chunkrow(row)) * 768 + (row & 31) * 16 + 4 * fq
                                        : dst + ((size_t)((c0 >> 4) + wn * 2) * M + row) * 16 + 4 * fq;
                    const size_t gstep = nt < 4 ? (size_t)1040 * 768 : (size_t)M * 16;
                    store_bf16x4(rp, v0[0], v0[1], v0[2], v0[3]);
                    store_bf16x4(rp + gstep, v1[0], v1[1], v1[2], v1[3]);
                }
            }
        } else if (nt < 12) {
            const int h = nt - 8;
            const float lgf = -expf(p.in(I_RDF)[l * 4 + h]), lgb = -expf(p.in(I_RDB)[l * 4 + h]);
            bf16_t* Kd = (bf16_t*)(p.ws() + OFF_K); bf16_t* KTF = (bf16_t*)(p.ws() + OFF_KTF); bf16_t* KTB = (bf16_t*)(p.ws() + OFF_KTB);
            const int sec = wn >> 1;
            f32x4 rc[NA], rs[NA];
#pragma unroll
            for (int a = 0; a < NA; ++a) {
                const RowInfo ri = row_info(rowbase + a * 16 + (lane & 15));
                const int pos = ri.lat ? (sec ? (ri.t & 63) : (ri.t >> 6)) : 0;
                const float* cs = rope + (sec ? 16384 : 0) + pos * 32 + (wn & 1) * 16 + 4 * fq;
                rc[a] = *(const f32x4*)cs; rs[a] = *(const f32x4*)(cs + (sec ? 2048 : 8192));
            }
#pragma unroll
            for (int a = 0; a < NA; ++a) {
                const int row = rowbase + a * 16 + (lane & 15);
                const RowInfo ri = row_info(row);
                f32x4 v0 = acc[a][0], v1 = acc[a][1];
                if (ri.lat) {
#pragma unroll
                    for (int r = 0; r < 4; ++r) { const float c = rc[a][r], s_ = rs[a][r], t1 = v0[r], t2 = v1[r]; v0[r] = t1 * c - t2 * s_; v1[r] = t1 * s_ + t2 * c; }
                }
                v0 *= 0.08838834764831845f; v1 *= 0.08838834764831845f;
                bf16_t* rp = Kd + ((size_t)(h * 8 + wn * 2) * M + row) * 16 + 4 * fq;
                store_bf16x4(rp, v0[0], v0[1], v0[2], v0[3]);
                store_bf16x4(rp + (size_t)M * 16, v1[0], v1[1], v1[2], v1[3]);
                const int c_ = ri.t & 127;
                const float ff = __expf(lgf * (float)(127 - c_)), fb = __expf(lgb * (float)c_);
                const size_t tb = ((size_t)(ri.b * 4 + h) * 128 + wn * 32 + 4 * fq) * TS + ri.ts;
#pragma unroll
                for (int r = 0; r < 4; ++r) {
                    KTF[tb + (size_t)r * TS] = f2bf(v0[r] * ff); KTF[tb + (size_t)(r + 16) * TS] = f2bf(v1[r] * ff);
                    KTB[tb + (size_t)r * TS] = f2bf(v0[r] * fb); KTB[tb + (size_t)(r + 16) * TS] = f2bf(v1[r] * fb);
                }
            }
        } else {
            const int h = nt - 12;
            bf16_t* VT = (bf16_t*)(p.ws() + OFF_VT);
#pragma unroll
            for (int a = 0; a < NA; ++a) {
                const int row = rowbase + a * 16 + (lane & 15);
                const RowInfo ri = row_info(row);
                const size_t tb = ((size_t)(ri.b * 4 + h) * 128 + wn * 32 + 4 * fq) * TS + ri.ts;
#pragma unroll
                for (int r = 0; r < 4; ++r) { VT[tb + (size_t)r * TS] = f2bf(acc[a][0][r]); VT[tb + (size_t)(r + 16) * TS] = f2bf(acc[a][1][r]); }
            }
        }
    }
    struct Pre {};
    static constexpr bool PAIR = false;
    template <int NA> __device__ __forceinline__ void prefetch(Pre&, int, int, int, int) const {}
    template <int NA> __device__ __forceinline__ void apply(const f32x4 (&acc)[NA][2], const Pre&, int rowbase, int nt, int wn, int lane) const { this->template operator()<NA>(acc, rowbase, nt, wn, lane); }
};
__device__ __forceinline__ void phase_g1(const Ctx& p, int l, LAS unsigned char* lds) {
    const bf16_t* A = (const bf16_t*)(p.ws() + OFF_H); const bf16_t* Bt = (const bf16_t*)(wsw(p, l) + OFF_WINT);
    pg8::Gemm g{A, Bt, ML, INC, D};
    pg8::StaticOrder S; S.init(ML, INC, (int)gridDim.x, (int)blockIdx.x);
    pg8::gemm_phase(lds, g, S, EpiG1{p, l});
    thin_ctx_gemm<true>(A, Bt, D, 0, 36, EpiG1{p, l}, lds);
}

__device__ __forceinline__ void phase_x1(const Ctx& p, int l, LAS unsigned char* lds) {
    const bf16_t* AS5 = (const bf16_t*)(p.ws() + OFF_AS5);
    constexpr int N_S5 = 32 * 9 * 2, N_RET = NB * 4 * 2 * 130;
    const int xcl = blockIdx.x & 7, xrk = blockIdx.x >> 3, xnp = gridDim.x >> 3;
    {
        const bf16_t* W = (const bf16_t*)(wsw(p, l) + OFF_S5W);
        float* SB = (float*)(p.ws() + OFF_SBUF);
        const int nloc = (4 * 16 - xrk + xnp - 1) / xnp;
        auto idf = [=](int i) { const int tq = xrk + i * xnp; return (xcl + 8 * (tq / 16)) * 18 + tq % 16; };
        auto ldf = [=](int id, int r, int k, const bf16_t*& pa, const bf16_t*& pb) {
            const int g = id / 18, r_ = id - g * 18, mt = r_ >> 1, nt = r_ & 1;
            int R = mt * 128 + r; R = R < 1040 ? R : 1039;
            pa = AS5 + ((size_t)g * 1040 + R) * 768 + k;
            pb = W + ((size_t)g * 256 + nt * 128 + r) * 512 + k;
        };
        auto epf = [=](int id, const f32x4 (&acc)[4][2], int wm, int wn, int lane) {
            const int g = id / 18, r_ = id - g * 18, mt = r_ >> 1, nt = r_ & 1;
#pragma unroll
            for (int a = 0; a < 4; ++a) {
                const int R = mt * 128 + wm * 64 + a * 16 + (lane & 15);
                if (R < 1040) {
#pragma unroll
                    for (int b2 = 0; b2 < 2; ++b2) *(f32x4*)(SB + ((size_t)g * 1040 + R) * 256 + nt * 128 + wn * 32 + b2 * 16 + 4 * (lane >> 4)) = acc[a][b2];
                }
            }
        };
        tile_stream<8>(nloc, idf, ldf, epf, lds);
        if (xrk < 8) {
            const int tid = tid_opaque(), lane = tid & 63, wid = __builtin_amdgcn_readfirstlane(tid >> 6), fr = lane & 15, fq = lane >> 4;
            const int g = xcl + 8 * (xrk >> 1), nt = xrk & 1;
            const bf16_t* Ap = AS5 + ((size_t)g * 1040 + 1024 + fr) * 768 + fq * 8;
            const bf16_t* Bp = W + ((size_t)g * 256 + nt * 128 + wid * 16 + fr) * 512 + fq * 8;
            f32x4 acc0 = {0.f, 0.f, 0.f, 0.f}, acc1 = {0.f, 0.f, 0.f, 0.f};
#pragma unroll
            for (int h = 0; h < 2; ++h) {
                bf16x8 av[8], bv[8];
#pragma unroll
                for (int j = 0; j < 8; ++j) { av[j] = *(const bf16x8*)(Ap + (h * 8 + j) * 32); bv[j] = *(const bf16x8*)(Bp + (h * 8 + j) * 32); }
#pragma unroll
                for (int j = 0; j < 8; j += 2) {
                    acc0 = __builtin_amdgcn_mfma_f32_16x16x32_bf16(bv[j], av[j], acc0, 0, 0, 0);
                    acc1 = __builtin_amdgcn_mfma_f32_16x16x32_bf16(bv[j + 1], av[j + 1], acc1, 0, 0, 0);
                }
            }
            *(f32x4*)(SB + ((size_t)g * 1040 + 1024 + fr) * 256 + nt * 128 + wid * 16 + 4 * fq) = acc0 + acc1;
        }
    }
    {
        const bf16_t* VT = (const bf16_t*)(p.ws() + OFF_VT); const bf16_t* KTF = (const bf16_t*)(p.ws() + OFF_KTF); const bf16_t* KTB = (const bf16_t*)(p.ws() + OFF_KTB);
        bf16_t* KVo = (bf16_t*)(p.ws() + OFF_KV);
        const int first = (blockIdx.x + 64) % gridDim.x;
        const int nloc = (N_RET - first + (int)gridDim.x - 1) / (int)gridDim.x;
        auto idf = [=](int i) { return first + i * (int)gridDim.x; };
        auto ldf = [=](int q, int r, int k, const bf16_t*& pa, const bf16_t*& pb) {
            const int n = q % 130, dir = (q / 130) & 1, bh = q / 260;
            pa = VT + ((size_t)bh * 128 + r) * TS + n * 128 + k;
            pb = (dir ? KTB : KTF) + ((size_t)bh * 128 + r) * TS + n * 128 + k;
        };
        auto epf = [=](int q, const f32x4 (&acc)[4][2], int wm, int wn, int lane) {
            const int n = q % 130, dir = (q / 130) & 1, bh = q / 260;
            bf16_t* KV = KVo + ((size_t)(bh * 2 + dir) * 130 + n) * 16384;
#pragma unroll
            for (int a = 0; a < 4; ++a)
#pragma unroll
                for (int b2 = 0; b2 < 2; ++b2)
                    store_bf16x4(KV + (wm * 64 + a * 16 + (lane & 15)) * 128 + wn * 32 + b2 * 16 + 4 * (lane >> 4), acc[a][b2][0], acc[a][b2][1], acc[a][b2][2], acc[a][b2][3]);
        };
        tile_stream<2>(nloc, idf, ldf, epf, lds);
    }
}

__device__ __forceinline__ void phase_x2(const Ctx& p, int l, LAS unsigned char* lds) {
    const int tid = tid_opaque();
    {
        const int gid = blockIdx.x * NT + tid;
        if (gid < 16 * 8192) {
            const int seq = gid >> 13, off = (gid & 8191) * 2, dir = seq & 1, h = (seq >> 1) & 3;
            const float lg = -expf(p.in(dir ? I_RDB : I_RDF)[l * 4 + h]);
            const float dec = expf(128.f * lg);
            const bf16_t* KV = (const bf16_t*)(p.ws() + OFF_KV) + (size_t)seq * 130 * 16384 + off;
            bf16_t* SB = (bf16_t*)(p.ws() + OFF_SBEF) + (size_t)seq * 130 * 16384 + off;
            float s0 = 0.f, s1 = 0.f;
#pragma unroll 1
            for (int v0 = 0; v0 < 130; v0 += 26) {
                unsigned kv[26];
#pragma unroll
                for (int j = 0; j < 26; ++j) { const int v = v0 + j, n = dir ? 129 - v : (v < 2 ? 128 + v : v - 2); kv[j] = *(const unsigned*)(KV + (size_t)n * 16384); }
#pragma unroll
                for (int j = 0; j < 26; ++j) {
                    const int v = v0 + j, n = dir ? 129 - v : (v < 2 ? 128 + v : v - 2);
                    *(unsigned*)(SB + (size_t)n * 16384) = pack_bf16(s0, s1);
                    s0 = dec * s0 + __uint_as_float(kv[j] << 16); s1 = dec * s1 + __uint_as_float(kv[j] & 0xFFFF0000u);
                }
            }
        }
    }
    if (blockIdx.x < 128) {
        const int u = blockIdx.x, b = u >> 6, g = (u >> 1) & 31, dir = u & 1;
        LAS float* tot = (LAS float*)lds;
        const float* SBUF = (const float*)(p.ws() + OFF_SBUF) + ((size_t)g * 1040 + b * 520) * 256 + dir * 128;
        bf16_t* HIN = (bf16_t*)(p.ws() + OFF_AS5) + ((size_t)g * 1040 + b * 520) * 768 + 512 + dir * 128;
        const int seg = tid >> 6, pp = tid & 63, v0 = seg * 65;
        const float* AT = (const float*)(wsw(p, l) + OFF_S5AT) + ((g * 2 + dir) * 64 + pp) * 2;
        const float ar = AT[0], ai = AT[1];
        float hr = 0.f, hi = 0.f;
#pragma unroll 13
        for (int i = 0; i < 65; ++i) {
            const int v = v0 + i, cs = dir ? 519 - v : (v < 8 ? 512 + v : v - 8);
            const float sr = SBUF[(size_t)cs * 256 + pp], si = SBUF[(size_t)cs * 256 + 64 + pp];
            const float nr = ar * hr - ai * hi + sr, ni = ar * hi + ai * hr + si;
            hr = nr; hi = ni;
        }
        tot[(seg * 64 + pp) * 2] = hr; tot[(seg * 64 + pp) * 2 + 1] = hi;
        float br = 1.f, bi = 0.f;
        for (int i = 0; i < 65; ++i) { const float nr = br * ar - bi * ai, ni = br * ai + bi * ar; br = nr; bi = ni; }
        __syncthreads();
        hr = 0.f; hi = 0.f;
        for (int s2 = 0; s2 < seg; ++s2) {
            const float tr = tot[(s2 * 64 + pp) * 2], ti = tot[(s2 * 64 + pp) * 2 + 1];
            const float nr = br * hr - bi * hi + tr, ni = br * hi + bi * hr + ti;
            hr = nr; hi = ni;
        }
#pragma unroll 1
        for (int i0 = 0; i0 < 65; i0 += 13) {
            float sr[13], si[13];
#pragma unroll
            for (int j = 0; j < 13; ++j) { const int v = v0 + i0 + j, cs = dir ? 519 - v : (v < 8 ? 512 + v : v - 8); sr[j] = SBUF[(size_t)cs * 256 + pp]; si[j] = SBUF[(size_t)cs * 256 + 64 + pp]; }
#pragma unroll
            for (int j = 0; j < 13; ++j) {
                const int v = v0 + i0 + j, cs = dir ? 519 - v : (v < 8 ? 512 + v : v - 8);
                HIN[(size_t)cs * 768 + pp] = f2bf(hr); HIN[(size_t)cs * 768 + 64 + pp] = f2bf(hi);
                const float nr = ar * hr - ai * hi + sr[j], ni = ar * hi + ai * hr + si[j];
                hr = nr; hi = ni;
            }
        }
        __syncthreads();
    }
}

struct S5cOrder {
    int c;
    __device__ __forceinline__ bool next(int i, pg8::Unit& u) const {
        if (i > 0) return false;
        const int xcl = c & 7, xrk = c >> 3, g = xcl + 8 * (xrk >> 3);
        u.pm = g * 4 + ((xrk & 7) >> 1); u.pn = xrk & 1; return true;
    }
    __device__ __forceinline__ const char* abase(const pg8::Gemm& g, const pg8::Unit& u) const { return (const char*)g.A + ((size_t)(u.pm >> 2) * 1040 + (u.pm & 3) * 256) * (768 * 2); }
    __device__ __forceinline__ const char* bbase(const pg8::Gemm& g, const pg8::Unit& u) const { return (const char*)g.Bt + ((size_t)(u.pm >> 2) * 512 + u.pn * 256) * (768 * 2); }
};
struct EpiS5C {
    const Ctx& p;
    struct Pre {};
    static constexpr bool PAIR = false;
    template <int NA> __device__ __forceinline__ void prefetch(Pre&, int, int, int, int) const {}
    template <int NA>
    __device__ __forceinline__ void apply(const f32x4 (&acc)[NA][2], const Pre&, int rowbase, int nt, int wn, int lane_) const {
        int lane = lane_; asm volatile("" : "+v"(lane));
        bf16_t* YS = (bf16_t*)(p.ws() + OFF_YS);
        const int g = rowbase >> 10;
#pragma unroll
        for (int a = 0; a < NA; ++a) {
            const int rb = s5_rowbase((rowbase & 1023) + a * 16 + (lane & 15));
#pragma unroll
            for (int b2 = 0; b2 < 2; ++b2) {
                const int n = nt * 128 + wn * 32 + b2 * 16 + 4 * (lane >> 4), t = n >> 4, i = n & 15;
                store_bf16x4(YS + (size_t)(rb + t) * 512 + g * 16 + i, gelu_tanh_f(acc[a][b2][0]), gelu_tanh_f(acc[a][b2][1]), gelu_tanh_f(acc[a][b2][2]), gelu_tanh_f(acc[a][b2][3]));
            }
        }
    }
};
__device__ __forceinline__ void phase_x3(const Ctx& p, int l, LAS unsigned char* lds) {
    const int tid = tid_opaque(), lane = tid & 63, wid = __builtin_amdgcn_readfirstlane(tid >> 6), wm = wid >> 2, wn = wid & 3;
    constexpr int N_RET = NB * 4 * 130;
    const int xcl = blockIdx.x & 7, xrk = blockIdx.x >> 3;
    {
        pg8::Gemm g{(const bf16_t*)(p.ws() + OFF_AS5), (const bf16_t*)(wsw(p, l) + OFF_S5TV), 32 * 1024, 512, 768};
        S5cOrder S; S.c = (int)blockIdx.x;
        pg8::gemm_phase(lds, g, S, EpiS5C{p});
    }
    if (xrk < 16) {
        const int g = xcl + 8 * (xrk >> 2), nt = xrk & 3, fr = lane & 15, fq = lane >> 4;
        const bf16_t* Ap = (const bf16_t*)(p.ws() + OFF_AS5) + ((size_t)g * 1040 + 1024 + fr) * 768 + fq * 8;
        const bf16_t* Bp = (const bf16_t*)(wsw(p, l) + OFF_S5TV) + ((size_t)g * 512 + nt * 128 + wid * 16 + fr) * 768 + fq * 8;
        f32x4 acc0 = {0.f, 0.f, 0.f, 0.f}, acc1 = {0.f, 0.f, 0.f, 0.f};
#pragma unroll
        for (int h = 0; h < 2; ++h) {
            bf16x8 av[12], bv[12];
#pragma unroll
            for (int j = 0; j < 12; ++j) { av[j] = *(const bf16x8*)(Ap + (h * 12 + j) * 32); bv[j] = *(const bf16x8*)(Bp + (h * 12 + j) * 32); }
#pragma unroll
            for (int j = 0; j < 12; j += 2) {
                acc0 = __builtin_amdgcn_mfma_f32_16x16x32_bf16(bv[j], av[j], acc0, 0, 0, 0);
                acc1 = __builtin_amdgcn_mfma_f32_16x16x32_bf16(bv[j + 1], av[j + 1], acc1, 0, 0, 0);
            }
        }
        const f32x4 acc = acc0 + acc1;
        bf16_t* YS = (bf16_t*)(p.ws() + OFF_YS);
        const int rb = s5_rowbase(1024 + fr), t = nt * 8 + wid;
        store_bf16x4(YS + (size_t)(rb + t) * 512 + g * 16 + 4 * fq, gelu_tanh_f(acc[0]), gelu_tanh_f(acc[1]), gelu_tanh_f(acc[2]), gelu_tanh_f(acc[3]));
    }
    {
        using pg8::HTB; using pg8::lds_byte; using pg8::stage_rc;
        constexpr int QO = 0, S0 = 2 * HTB, S1 = 4 * HTB, PO = 6 * HTB, RED = 8 * HTB;
        const int fr = lane & 15, fq = lane >> 4;
        int sR[2], sC[2];
#pragma unroll
        for (int i = 0; i < 2; ++i) stage_rc(tid * 16 + i * 8192, sR[i], sC[i]);
        const unsigned ldsw = (unsigned)wid * 1024u;
        const int aoff = lds_byte(wm * 64 + fr, fq * 8), boff = lds_byte(wn * 32 + fr, fq * 8);
#define RC_STAGE(off, base, ld) do { _Pragma("unroll") for (int _kh = 0; _kh < 2; ++_kh) { _Pragma("unroll") for (int _i = 0; _i < 2; ++_i) \
            __builtin_amdgcn_global_load_lds((const unsigned*)((base) + (size_t)sR[_i] * (ld) + sC[_i] + 64 * _kh), (LAS unsigned*)(lds + (off) + _kh * HTB + ldsw + _i * 8192), 16, 0, 0); } } while (0)
#define RC_STAGE_G(off, base) do { _Pragma("unroll") for (int _kh = 0; _kh < 2; ++_kh) { _Pragma("unroll") for (int _i = 0; _i < 2; ++_i) \
            __builtin_amdgcn_global_load_lds((const unsigned*)((base) + ((size_t)((sC[_i] + 64 * _kh) >> 4) * M + sR[_i]) * 16 + (sC[_i] & 15)), (LAS unsigned*)(lds + (off) + _kh * HTB + ldsw + _i * 8192), 16, 0, 0); } } while (0)
#define RC_MMA(aimg, bimg) do { _Pragma("unroll") for (int _k = 0; _k < 4; ++_k) { bf16x8 _af[4], _bf[2]; \
            _Pragma("unroll") for (int m = 0; m < 4; ++m) _af[m] = *(const LAS bf16x8*)(lds + (aimg) + (_k >> 1) * HTB + aoff + m * 2048 + (_k & 1) * 1024); \
            _Pragma("unroll") for (int n2 = 0; n2 < 2; ++n2) _bf[n2] = *(const LAS bf16x8*)(lds + (bimg) + (_k >> 1) * HTB + boff + n2 * 2048 + (_k & 1) * 1024); \
            _Pragma("unroll") for (int m = 0; m < 4; ++m) _Pragma("unroll") for (int n2 = 0; n2 < 2; ++n2) \
                acc[m][n2] = __builtin_amdgcn_mfma_f32_16x16x32_bf16(_bf[n2], _af[m], acc[m][n2], 0, 0, 0); } } while (0)
#define RC_WAIT(n) asm volatile("s_waitcnt vmcnt(" #n ")" ::: "memory")
#define RC_BAR() do { asm volatile("s_waitcnt lgkmcnt(0)" ::: "memory"); __builtin_amdgcn_s_barrier(); asm volatile("" ::: "memory"); } while (0)
#pragma unroll 1
        for (int id = (blockIdx.x + gridDim.x / 2) % gridDim.x; id < N_RET; id += gridDim.x) {
            const int n = id % 130, bh = id / 130, h = bh & 3, b = bh >> 2;
            if (l == DEPTH - 1 && n >= 128) continue;
            const int rowbase = n < 128 ? b * SEQ + n * 128 : ML + b * CTX + (n - 128) * 128;
            const float lgf = -expf(p.in(I_RDF)[l * 4 + h]), lgb = -expf(p.in(I_RDB)[l * 4 + h]);
            const bf16_t* Qb = (const bf16_t*)(p.ws() + OFF_Q) + ((size_t)(h * 8) * M + rowbase) * 16;
            const bf16_t* Kb = (const bf16_t*)(p.ws() + OFF_K) + ((size_t)(h * 8) * M + rowbase) * 16;
            const bf16_t* Sf = (const bf16_t*)(p.ws() + OFF_SBEF) + ((size_t)(bh * 2 + 0) * 130 + n) * 16384;
            const bf16_t* Rb = (const bf16_t*)(p.ws() + OFF_SBEF) + ((size_t)(bh * 2 + 1) * 130 + n) * 16384;
            const bf16_t* Vb = (const bf16_t*)(p.ws() + OFF_VT) + (size_t)bh * 128 * TS + n * 128;
            const bf16_t* G = (const bf16_t*)(p.ws() + OFF_G) + ((size_t)(h * 8) * M + rowbase) * 16;
            uint2 gv[4][2];
#pragma unroll
            for (int a = 0; a < 4; ++a)
#pragma unroll
                for (int b2 = 0; b2 < 2; ++b2) gv[a][b2] = *(const uint2*)(G + ((size_t)(wn * 2 + b2) * M + wm * 64 + a * 16 + fr) * 16 + 4 * fq);
            RC_STAGE_G(QO, Qb); RC_STAGE_G(S0, Kb); RC_STAGE(S1, Rb, 128);
            f32x4 acc[4][2]; zero_acc(acc);
            RC_WAIT(4); RC_BAR();
            RC_MMA(QO, S0);
#pragma unroll
            for (int a = 0; a < 4; ++a) {
                const int c = wm * 64 + a * 16 + fr;
#pragma unroll
                for (int b2 = 0; b2 < 2; ++b2) {
                    const int m0 = wn * 32 + b2 * 16 + 4 * fq;
                    float pv[4];
#pragma unroll
                    for (int r = 0; r < 4; ++r) { const int m = m0 + r; pv[r] = acc[a][b2][r] * (c >= m ? __expf(lgf * (float)(c - m)) : __expf(lgb * (float)(m - c))); }
                    u32x2 o; o[0] = pack_bf16(pv[0], pv[1]); o[1] = pack_bf16(pv[2], pv[3]);
                    *(LAS u32x2*)(lds + PO + (m0 >> 6) * HTB + lds_byte(c, m0 & 63)) = o;
                }
            }
            RC_BAR();
            RC_STAGE(S0, Sf, 128);
            zero_acc(acc);
            RC_WAIT(4); RC_BAR();
            RC_MMA(QO, S1);
#pragma unroll
            for (int a = 0; a < 4; ++a) {
                const int c = wm * 64 + a * 16 + fr;
                const float rr = __expf(lgb * (float)(128 - c) - lgf * (float)(c + 1));
#pragma unroll
                for (int b2 = 0; b2 < 2; ++b2)
#pragma unroll
                    for (int r = 0; r < 4; ++r) acc[a][b2][r] *= rr;
            }
            RC_BAR();
            RC_STAGE(S1, Vb, TS);
            RC_WAIT(4); RC_BAR();
            RC_MMA(QO, S0);
#pragma unroll
            for (int a = 0; a < 4; ++a) {
                const int c = wm * 64 + a * 16 + fr;
                const float ff = __expf(lgf * (float)(c + 1));
#pragma unroll
                for (int b2 = 0; b2 < 2; ++b2)
#pragma unroll
                    for (int r = 0; r < 4; ++r) acc[a][b2][r] *= ff;
            }
            RC_WAIT(0); RC_BAR();
            RC_MMA(PO, S1);
            LAS float* red = (LAS float*)(lds + RED);
#pragma unroll
            for (int a = 0; a < 4; ++a) {
                float ss = 0.f;
#pragma unroll
                for (int b2 = 0; b2 < 2; ++b2)
#pragma unroll
                    for (int r = 0; r < 4; ++r) ss += acc[a][b2][r] * acc[a][b2][r];
                ss += __shfl_xor(ss, 16); ss += __shfl_xor(ss, 32);
                if (lane < 16) red[wn * 128 + wm * 64 + a * 16 + lane] = ss;
            }
            RC_BAR();
            bf16_t* YR = (bf16_t*)(p.ws() + OFF_YR);
#pragma unroll
            for (int a = 0; a < 4; ++a) {
                const int c = wm * 64 + a * 16 + fr;
                const float tot = red[c] + red[128 + c] + red[256 + c] + red[384 + c];
                const float rstd = rsqrtf(tot * (1.f / 128.f) + EPS);
#pragma unroll
                for (int b2 = 0; b2 < 2; ++b2) {
                    const int e = wn * 32 + b2 * 16 + 4 * fq;
                    const uint2 g_ = gv[a][b2];
                    const float g0 = __uint_as_float(g_.x << 16), g1 = __uint_as_float(g_.x & 0xFFFF0000u), g2 = __uint_as_float(g_.y << 16), g3 = __uint_as_float(g_.y & 0xFFFF0000u);
                    store_bf16x4(YR + (size_t)(rowbase + c) * 512 + h * 128 + e, acc[a][b2][0] * rstd * silu_f(g0), acc[a][b2][1] * rstd * silu_f(g1),
                                 acc[a][b2][2] * rstd * silu_f(g2), acc[a][b2][3] * rstd * silu_f(g3));
                }
            }
            RC_BAR();
        }
#undef RC_STAGE
#undef RC_STAGE_G
#undef RC_MMA
#undef RC_WAIT
#undef RC_BAR
    }
}

struct EpiG2 {
    const Ctx& p;
    struct Pre { uint2 gs[4]; };
    static constexpr bool PAIR = true;
    template <int NA>
    __device__ __forceinline__ void prefetch(Pre& q, int rowbase, int nt, int wn, int lane) const {
        const bf16_t* GS = (const bf16_t*)(p.ws() + OFF_GS);
#pragma unroll
        for (int a = 0; a < NA; ++a) q.gs[a] = *(const uint2*)(GS + ((size_t)(nt * 4 + wn) * M + rowbase + a * 16 + (lane & 15)) * 16 + 4 * (lane >> 4));
    }
    template <int NA>
    __device__ __forceinline__ void apply(const f32x4 (&acc)[NA][2], const Pre& q, int rowbase, int nt, int wn, int lane) const {
        bf16_t* MP = (bf16_t*)(p.ws() + OFF_H);
#pragma unroll
        for (int a = 0; a < NA; ++a) {
            const int row = rowbase + a * 16 + (lane & 15), j = nt * 64 + wn * 16 + 4 * (lane >> 4);
            const uint2 gv = q.gs[a];
            const float s0 = sigmoid_f(__uint_as_float(gv.x << 16)), s1 = sigmoid_f(__uint_as_float(gv.x & 0xFFFF0000u));
            const float s2 = sigmoid_f(__uint_as_float(gv.y << 16)), s3 = sigmoid_f(__uint_as_float(gv.y & 0xFFFF0000u));
            store_bf16x4(MP + (size_t)row * D + j, acc[a][0][0] * sigmoid_f(acc[a][1][0]) * s0, acc[a][0][1] * sigmoid_f(acc[a][1][1]) * s1,
                         acc[a][0][2] * sigmoid_f(acc[a][1][2]) * s2, acc[a][0][3] * sigmoid_f(acc[a][1][3]) * s3);
        }
    }
};
struct EpiG3 {
    const Ctx& p;
    struct Pre { uint2 gr[4][2], mp[4][2]; };
    static constexpr bool PAIR = true;
    template <int NA>
    __device__ __forceinline__ void prefetch(Pre& q, int rowbase, int nt, int wn, int lane) const {
        const bf16_t* GR = (const bf16_t*)(p.ws() + OFF_GR); const bf16_t* MP = (const bf16_t*)(p.ws() + OFF_H);
#pragma unroll
        for (int a = 0; a < NA; ++a)
#pragma unroll
            for (int b2 = 0; b2 < 2; ++b2) {
                const size_t o = (size_t)(rowbase + a * 16 + (lane & 15)) * D + nt * 128 + wn * 32 + b2 * 16 + 4 * (lane >> 4);
                q.gr[a][b2] = *(const uint2*)(GR + ((size_t)(nt * 8 + wn * 2 + b2) * M + rowbase + a * 16 + (lane & 15)) * 16 + 4 * (lane >> 4));
                q.mp[a][b2] = *(const uint2*)(MP + o);
            }
    }
    template <int NA>
    __device__ __forceinline__ void apply(const f32x4 (&acc)[NA][2], const Pre& q, int rowbase, int nt, int wn, int lane) const {
        bf16_t* MP = (bf16_t*)(p.ws() + OFF_H);
#pragma unroll
        for (int a = 0; a < NA; ++a)
#pragma unroll
            for (int b2 = 0; b2 < 2; ++b2) {
                const int row = rowbase + a * 16 + (lane & 15), col = nt * 128 + wn * 32 + b2 * 16 + 4 * (lane >> 4);
                const uint2 gv = q.gr[a][b2], mv = q.mp[a][b2];
                store_bf16x4(MP + (size_t)row * D + col,
                             __uint_as_float(mv.x << 16) + sigmoid_f(__uint_as_float(gv.x << 16)) * acc[a][b2][0],
                             __uint_as_float(mv.x & 0xFFFF0000u) + sigmoid_f(__uint_as_float(gv.x & 0xFFFF0000u)) * acc[a][b2][1],
                             __uint_as_float(mv.y << 16) + sigmoid_f(__uint_as_float(gv.y << 16)) * acc[a][b2][2],
                             __uint_as_float(mv.y & 0xFFFF0000u) + sigmoid_f(__uint_as_float(gv.y & 0xFFFF0000u)) * acc[a][b2][3]);
            }
    }
};
struct EpiG4 {
    const Ctx& p; int l;
    struct Pre { f32x4 x[4][2]; };
    static constexpr bool PAIR = false;
    template <int NA>
    __device__ __forceinline__ void prefetch(Pre& q, int rowbase, int nt, int wn, int lane) const {
#pragma unroll
        for (int a = 0; a < NA; ++a) {
            const float* xin = x_row_ptr(p, l, 0, rowbase + a * 16 + (lane & 15));
#pragma unroll
            for (int b2 = 0; b2 < 2; ++b2) q.x[a][b2] = *(const f32x4*)(xin + nt * 128 + wn * 32 + b2 * 16 + 4 * (lane >> 4));
        }
    }
    template <int NA>
    __device__ __forceinline__ void apply(const f32x4 (&acc)[NA][2], const Pre& q, int rowbase, int nt, int wn, int lane) const {
        const float* modv = (const float*)(p.ws() + OFF_MODV) + (size_t)l * 3 * 6144;
#pragma unroll
        for (int a = 0; a < NA; ++a) {
            const int row = rowbase + a * 16 + (lane & 15);
            float* xo = row < ML ? p.out() + (size_t)row * D : (float*)(p.ws() + OFF_XC) + (size_t)(row - ML) * D;
            const float* g1 = modv + (size_t)mod_index(row) * 6144 + 2048;
#pragma unroll
            for (int b2 = 0; b2 < 2; ++b2) {
                const int col = nt * 128 + wn * 32 + b2 * 16 + 4 * (lane >> 4);
                const f32x4 gv = *(const f32x4*)(g1 + col);
                *(f32x4*)(xo + col) = q.x[a][b2] + gv * acc[a][b2];
            }
        }
    }
};
__device__ __forceinline__ void phase_g2(const Ctx& p, int l, LAS unsigned char* lds) {
    pg8::Gemm g{(const bf16_t*)(p.ws() + OFF_YS), (const bf16_t*)(wsw(p, l) + OFF_WGLUT), ML, 2048, 512};
    pg8::StaticOrder S; S.init(ML, 2048, (int)gridDim.x, (int)blockIdx.x);
    pg8::gemm_phase(lds, g, S, EpiG2{p});
    if (l < DEPTH - 1) thin_ctx_gemm<true>(g.A, g.Bt, 512, 0, 16, EpiG2{p}, lds);
}
__device__ __forceinline__ void phase_g3(const Ctx& p, int l, LAS unsigned char* lds) {
    pg8::Gemm g{(const bf16_t*)(p.ws() + OFF_YR), (const bf16_t*)(wsw(p, l) + OFF_WRUT), ML, 1024, 512};
    pg8::StaticOrder S; S.init(ML, 1024, (int)gridDim.x, (int)blockIdx.x);
    pg8::gemm_phase(lds, g, S, EpiG3{p});
    if (l < DEPTH - 1) thin_ctx_gemm<true>(g.A, g.Bt, 512, 0, 8, EpiG3{p}, lds);
}
__device__ __forceinline__ void phase_g4(const Ctx& p, int l, LAS unsigned char* lds) {
    pg8::Gemm g{(const bf16_t*)(p.ws() + OFF_H), (const bf16_t*)(wsw(p, l) + OFF_WOUTT), ML, 1024, 1024};
    pg8::StaticOrder S; S.init(ML, 1024, (int)gridDim.x, (int)blockIdx.x);
    pg8::gemm_phase(lds, g, S, EpiG4{p, l});
    if (l < DEPTH - 1) thin_ctx_gemm<true>(g.A, g.Bt, 1024, 0, 8, EpiG4{p, l}, lds);
}

struct EpiG5 {
    const Ctx& p;
    template <int NA>
    __device__ __forceinline__ void operator()(const f32x4 (&acc)[NA][2], int rowbase, int nt, int wn, int lane) const {
        bf16_t* QP = (bf16_t*)(p.ws() + OFF_QP);
#pragma unroll
        for (int a = 0; a < NA; ++a)
#pragma unroll
            for (int b = 0; b < 2; ++b) {
                const int row = rowbase + a * 16 + (lane & 15);
                store_bf16x4(QP + ((size_t)(nt * 8 + wn * 2 + b) * M + row) * 16 + 4 * (lane >> 4), acc[a][b][0], acc[a][b][1], acc[a][b][2], acc[a][b][3]);
            }
    }
    struct Pre {};
    static constexpr bool PAIR = false;
    template <int NA> __device__ __forceinline__ void prefetch(Pre&, int, int, int, int) const {}
    template <int NA> __device__ __forceinline__ void apply(const f32x4 (&acc)[NA][2], const Pre&, int rowbase, int nt, int wn, int lane) const { this->template operator()<NA>(acc, rowbase, nt, wn, lane); }
};
__device__ __forceinline__ void phase_g5(const Ctx& p, int l, LAS unsigned char* lds) {
    pg8::Gemm g{(const bf16_t*)(p.ws() + OFF_H), (const bf16_t*)(wsw(p, l) + OFF_WQT), ML, 1024, 1024};
    pg8::StaticOrder S; S.init(ML, 1024, (int)gridDim.x, (int)blockIdx.x);
    pg8::gemm_phase(lds, g, S, EpiG5{p});
    if (l < DEPTH - 1) thin_ctx_gemm<true>(g.A, g.Bt, 1024, 0, 8, EpiG5{p}, lds);
}

__device__ __forceinline__ unsigned f2ord(float f) { const unsigned b = __float_as_uint(f); return b ^ ((b >> 31) ? 0xFFFFFFFFu : 0x80000000u); }
__device__ __forceinline__ float ord2f(unsigned o) { return __uint_as_float((o >> 31) ? (o & 0x7FFFFFFFu) : ~o); }
#define CE_DESC(a, b) do { const unsigned _x = (a), _y = (b); (a) = _x > _y ? _x : _y; (b) = _x > _y ? _y : _x; } while (0)
struct Net16 { unsigned char a[63], b[63]; };
constexpr Net16 NET16 = {{0,2,4,6,8,10,12,14,0,1,4,5,8,9,12,13,1,5,9,13,0,1,2,3,8,9,10,11,2,3,10,11,1,3,5,9,11,13,0,1,2,3,4,5,6,7,4,5,6,7,2,3,6,7,10,11,1,3,5,7,9,11,13},
                         {1,3,5,7,9,11,13,15,2,3,6,7,10,11,14,15,2,6,10,14,4,5,6,7,12,13,14,15,4,5,12,13,2,4,6,10,12,14,8,9,10,11,12,13,14,15,8,9,10,11,4,5,8,9,12,13,2,4,6,8,10,12,14}};
__device__ __forceinline__ void sort16_desc(unsigned (&v)[16]) {
#pragma unroll
    for (int t = 0; t < 63; ++t) CE_DESC(v[NET16.a[t]], v[NET16.b[t]]);
}
__device__ __forceinline__ void bitonic_merge16_desc(unsigned (&v)[16]) {
#pragma unroll
    for (int j = 8; j > 0; j >>= 1)
#pragma unroll
        for (int i = 0; i < 16; ++i) { const int l = i ^ j; if (l > i) CE_DESC(v[i], v[l]); }
}
__device__ __forceinline__ void merge_top16(unsigned (&x)[16], const unsigned (&y)[16]) {
#pragma unroll
    for (int i = 0; i < 16; ++i) x[i] = x[i] > y[15 - i] ? x[i] : y[15 - i];
    bitonic_merge16_desc(x);
}
struct CandList { int i[64], j[64], n; };
constexpr CandList make_cands() {
    CandList c{}; c.n = 0;
    for (int i = 0; i < 16; ++i) for (int j = 0; j < 16; ++j) if ((i + 1) * (j + 1) <= 16) { c.i[c.n] = i; c.j[c.n] = j; ++c.n; }
    for (int k = c.n; k < 64; ++k) { c.i[k] = -1; c.j[k] = -1; }
    return c;
}
constexpr CandList CANDS = make_cands();
static_assert(CANDS.n == 50, "candidate count");

__device__ __forceinline__ void phase_select(const Ctx& p, int l, LAS unsigned char* lds) {
    const int tid = tid_opaque(), lane = tid & 63, wid = __builtin_amdgcn_readfirstlane(tid >> 6), tok = lane & 15, fq = lane >> 4;
    const bf16_t* QP = (const bf16_t*)(p.ws() + OFF_QP); const bf16_t* SK = (const bf16_t*)(wsw(p, l) + OFF_SKEY);
    int* IDX = (int*)(p.ws() + OFF_IDX); float* GATE = (float*)(p.ws() + OFF_GATE);
    LAS unsigned* myl = (LAS unsigned*)lds + wid * 2048 + lane;
    const int gw = blockIdx.x * 8 + wid, nw = gridDim.x * 8;
    const int NFULL = ((M / 16) / nw) * nw;
    const int nrem = (l == DEPTH - 1) ? 0 : (M / 16 - NFULL) * 4;
    const int nitems = NFULL / nw + (gw < nrem ? 1 : 0) + ((gw + nw) < nrem ? 1 : 0);
#pragma unroll 1
    for (int it = 0; it < nitems; ++it) {
        int task, hp_lo, hp_hi;
        if (it < NFULL / nw) { task = it * nw + gw; hp_lo = 0; hp_hi = 4; }
        else { const int e = gw + (it - NFULL / nw) * nw; task = NFULL + (e >> 2); hp_lo = e & 3; hp_hi = hp_lo + 1; }
        const int r0 = task * 16;
        unsigned LA0[2][16], LB0[2][16];
#pragma unroll
        for (int i = 0; i < 16; ++i) { LA0[0][i] = 0u; LA0[1][i] = 0u; LB0[0][i] = 0u; LB0[1][i] = 0u; }
        const bool use_lds = it < NFULL / nw;
#pragma unroll 1
        for (int hp = hp_lo; hp < hp_hi; ++hp) {
          if (use_lds) {
              __syncthreads();
#pragma unroll 2
              for (int i = 0; i < 8; ++i) {
                  const int pc = i * NT + tid, q = pc >> 10, row = (pc >> 3) & 127, c = (pc & 7) * 8;
                  *(LAS u32x4*)(lds + 65536 + ((q * 128 + row) * 72 + c) * 2) = *(const u32x4*)(SK + (size_t)((hp * 4 + q) * 128 + row) * 64 + c);
              }
              __syncthreads();
          }
#pragma unroll
          for (int hh = 0; hh < 2; ++hh) {
            const int h = hp * 2 + hh;
#pragma unroll
            for (int s = 0; s < 2; ++s) {
                f32x4 acc[8];
#pragma unroll
                for (int n = 0; n < 8; ++n) acc[n] = (f32x4){0.f, 0.f, 0.f, 0.f};
                const bf16_t* qrow = QP + ((size_t)(h * 8 + s * 4 + (fq >> 1)) * M + r0 + tok) * 16 + (fq & 1) * 8;
                const bf16x8 a0 = *(const bf16x8*)(qrow), a1 = *(const bf16x8*)(qrow + (size_t)2 * M * 16);
                const bf16_t* kb = SK + (size_t)((h * 2 + s) * 128 + tok) * 64 + fq * 8;
                const LAS unsigned char* kl = lds + 65536 + (((hh * 2 + s) * 128 + tok) * 72 + fq * 8) * 2;
                if (use_lds) {
#pragma unroll
                    for (int n = 0; n < 8; ++n) {
                        const bf16x8 b0 = *(const LAS bf16x8*)(kl + n * 16 * 144), b1 = *(const LAS bf16x8*)(kl + n * 16 * 144 + 64);
                        acc[n] = __builtin_amdgcn_mfma_f32_16x16x32_bf16(b0, a0, acc[n], 0, 0, 0);
                        acc[n] = __builtin_amdgcn_mfma_f32_16x16x32_bf16(b1, a1, acc[n], 0, 0, 0);
                    }
                } else {
#pragma unroll
                    for (int n = 0; n < 8; ++n) {
                        const bf16x8 b0 = *(const bf16x8*)(kb + n * 16 * 64), b1 = *(const bf16x8*)(kb + n * 16 * 64 + 32);
                        acc[n] = __builtin_amdgcn_mfma_f32_16x16x32_bf16(b0, a0, acc[n], 0, 0, 0);
                        acc[n] = __builtin_amdgcn_mfma_f32_16x16x32_bf16(b1, a1, acc[n], 0, 0, 0);
                    }
                }
                unsigned x[16], y[16];
#pragma unroll
                for (int n = 0; n < 4; ++n)
#pragma unroll
                    for (int r = 0; r < 4; ++r) {
                        x[n * 4 + r] = (f2ord(acc[n][r]) & ~127u) | (unsigned)(127 - (n * 16 + fq * 4 + r));
                        y[n * 4 + r] = (f2ord(acc[n + 4][r]) & ~127u) | (unsigned)(127 - ((n + 4) * 16 + fq * 4 + r));
                    }
                sort16_desc(x); sort16_desc(y); merge_top16(x, y);
#pragma unroll
                for (int i = 0; i < 16; ++i) y[i] = (unsigned)__shfl_xor((int)x[i], 16);
                merge_top16(x, y);
#pragma unroll
                for (int i = 0; i < 16; ++i) y[i] = (unsigned)__shfl_xor((int)x[i], 32);
                merge_top16(x, y);
                if (hp == fq) {
#pragma unroll
                    for (int i = 0; i < 16; ++i) { if (s == 0) LA0[hh][i] = x[i]; else LB0[hh][i] = x[i]; }
                }
            }
          }
        }
        if (fq >= hp_lo && fq < hp_hi)
#pragma unroll
        for (int hh = 0; hh < 2; ++hh) {
            const int head = fq * 2 + hh;
            float af[16], bfv[16];
#pragma unroll
            for (int i = 0; i < 16; ++i) {
                myl[i * 64] = LA0[hh][i]; myl[(16 + i) * 64] = LB0[hh][i];
                af[i] = ord2f(LA0[hh][i] & ~127u); bfv[i] = ord2f(LB0[hh][i] & ~127u);
            }
            unsigned c[4][16];
#pragma unroll
            for (int n = 0; n < 64; ++n) {
                unsigned key = 0u;
                if (CANDS.i[n] >= 0) key = (f2ord(af[CANDS.i[n] < 0 ? 0 : CANDS.i[n]] + bfv[CANDS.j[n] < 0 ? 0 : CANDS.j[n]]) & ~255u) | (unsigned)(255 - (CANDS.i[n] * 16 + CANDS.j[n]));
                c[n >> 4][n & 15] = key;
            }
            sort16_desc(c[0]); sort16_desc(c[1]); sort16_desc(c[2]); sort16_desc(c[3]);
            merge_top16(c[0], c[1]); merge_top16(c[2], c[3]); merge_top16(c[0], c[2]);
            float sc[16], se = 0.f; int eidx[16];
#pragma unroll
            for (int k = 0; k < 16; ++k) {
                const unsigned code = 255u - (c[0][k] & 255u);
                const unsigned ka = myl[(code >> 4) * 64], kbv = myl[(16 + (code & 15u)) * 64];
                eidx[k] = (int)((127u - (ka & 127u)) * 128u + (127u - (kbv & 127u)));
                sc[k] = ord2f(c[0][k] & ~255u);
            }
            const float mx = sc[0];
#pragma unroll
            for (int k = 0; k < 16; ++k) { sc[k] = __expf(sc[k] - mx); se += sc[k]; }
            const float inv = 1.f / se;
#pragma unroll
            for (int k = 0; k < 16; ++k) sc[k] *= inv;
            int* ip = IDX + (size_t)(r0 + tok) * 128 + head * 16; float* gp = GATE + (size_t)(r0 + tok) * 128 + head * 16;
#pragma unroll
            for (int k = 0; k < 16; k += 4) { *(int4*)(ip + k) = make_int4(eidx[k], eidx[k + 1], eidx[k + 2], eidx[k + 3]); }
#pragma unroll
            for (int k = 0; k < 16; k += 4) { *(float4*)(gp + k) = make_float4(sc[k], sc[k + 1], sc[k + 2], sc[k + 3]); }
        }
    }
}

__device__ __forceinline__ u32x4 row8_load(const unsigned char* T, int idx, int lane) { return *(const u32x4*)(T + (unsigned)(idx * D + lane * 16)); }
__device__ __forceinline__ float row8_dot(const u32x4& r, const f32x2 (&hv)[8]) {
    f32x2 acc = (f32x2){0.f, 0.f};
#pragma unroll
    for (int i = 0; i < 4; ++i) {
        acc += __builtin_amdgcn_cvt_pk_f32_fp8((int)r[i], false) * hv[2 * i];
        acc += __builtin_amdgcn_cvt_pk_f32_fp8((int)r[i], true) * hv[2 * i + 1];
    }
    return acc[0] + acc[1];
}
__device__ __forceinline__ void row8_axpy(f32x2 (&o)[8], const u32x4& r, float w) {
    const f32x2 w2 = (f32x2){w, w};
#pragma unroll
    for (int i = 0; i < 4; ++i) {
        o[2 * i] += w2 * __builtin_amdgcn_cvt_pk_f32_fp8((int)r[i], false);
        o[2 * i + 1] += w2 * __builtin_amdgcn_cvt_pk_f32_fp8((int)r[i], true);
    }
}
__device__ __forceinline__ float rl_f(float v, int l) { return __uint_as_float(__builtin_amdgcn_readlane(__float_as_uint(v), l)); }
struct GTok { int i0, i1; float dv[2]; float W[2]; f32x2 o[8]; };
struct GEnv { const unsigned char* PU; const unsigned char* PV; const float* SCU; const float* SCV; const bf16_t* H; const int* IDX; const float* GATE; };
__device__ __forceinline__ void gtok_setup(GTok& t, const GEnv& e, int row, int lane, LAS unsigned* sl, u32x4 (&hp)[2]) {
    t.i0 = e.IDX[(size_t)row * 128 + lane]; t.i1 = e.IDX[(size_t)row * 128 + 64 + lane];
    const float su0 = e.SCU[t.i0], su1 = e.SCU[t.i1];
    const float gv0 = e.GATE[(size_t)row * 128 + lane] * e.SCV[t.i0], gv1 = e.GATE[(size_t)row * 128 + 64 + lane] * e.SCV[t.i1];
    {
        const int b0 = t.i0 >> 10, b1 = t.i1 >> 10;
        int base = 0, pos0 = 0, pos1 = 0;
#pragma unroll 4
        for (int k = 0; k < 16; ++k) {
            const unsigned long long m0 = __ballot(b0 == k), m1 = __ballot(b1 == k);
            const int c0 = __popcll(m0);
            const int r0 = __builtin_amdgcn_mbcnt_hi((unsigned)(m0 >> 32), __builtin_amdgcn_mbcnt_lo((unsigned)m0, 0u));
            const int r1 = __builtin_amdgcn_mbcnt_hi((unsigned)(m1 >> 32), __builtin_amdgcn_mbcnt_lo((unsigned)m1, 0u));
            if (b0 == k) pos0 = base + r0;
            if (b1 == k) pos1 = base + c0 + r1;
            base += c0 + __popcll(m1);
        }
        sl[pos0] = (unsigned)t.i0; sl[128 + pos0] = __float_as_uint(su0); sl[256 + pos0] = __float_as_uint(gv0);
        sl[pos1] = (unsigned)t.i1; sl[128 + pos1] = __float_as_uint(su1); sl[256 + pos1] = __float_as_uint(gv1);
        t.i0 = (int)sl[lane]; t.i1 = (int)sl[64 + lane];
    }
    hp[0] = *(const u32x4*)(e.H + (size_t)row * D + lane * 16); hp[1] = *(const u32x4*)(e.H + (size_t)row * D + lane * 16 + 8);
    t.dv[0] = 0.f; t.dv[1] = 0.f;
}
__device__ __forceinline__ void gtok_weights(GTok& t, int lane, const LAS unsigned* sl) {
#pragma unroll
    for (int hf = 0; hf < 2; ++hf) {
        const int ex = 64 * hf + 16 * (lane & 3) + (lane >> 2);
        const float su = __uint_as_float(sl[128 + ex]), gw = __uint_as_float(sl[256 + ex]);
        t.W[hf] = gw * gelu_erf_f(su * t.dv[hf]);
    }
}
__device__ __forceinline__ void gather_epilogue(const Ctx& p, int l, int row, int lane, const f32x2 (&o)[8], const float* modv) {
    float* xr = (row < ML ? p.out() + (size_t)row * D : (float*)(p.ws() + OFF_XC) + (size_t)(row - ML) * D) + lane * 16;
    const float* g2 = modv + (size_t)mod_index(row) * 6144 + 5120 + lane * 16;
    const float* gn = (l == DEPTH - 1) ? p.in(I_FNG) + lane * 16 : p.in(I_N1G) + (l + 1) * D + lane * 16;
    const float* mv = modv + 3 * 6144 + (size_t)mod_index(row) * 6144 + lane * 16;
    f32x4 xa[4], ga[4], gq[4], sh[4], sc[4];
#pragma unroll
    for (int i = 0; i < 4; ++i) { xa[i] = *(const f32x4*)(xr + i * 4); ga[i] = *(const f32x4*)(g2 + i * 4); gq[i] = *(const f32x4*)(gn + i * 4); }
    if (l < DEPTH - 1) {
#pragma unroll
        for (int i = 0; i < 4; ++i) { sh[i] = *(const f32x4*)(mv + i * 4); sc[i] = *(const f32x4*)(mv + 1024 + i * 4); }
    }
    f32x4 xv[4];
#pragma unroll
    for (int i = 0; i < 4; ++i) xv[i] = xa[i] + ga[i] * (f32x4){o[2 * i][0], o[2 * i][1], o[2 * i + 1][0], o[2 * i + 1][1]};
    float ss = 0.f;
#pragma unroll
    for (int i = 0; i < 4; ++i) ss += xv[i][0] * xv[i][0] + xv[i][1] * xv[i][1] + xv[i][2] * xv[i][2] + xv[i][3] * xv[i][3];
    ss = wave_sum(ss);
    const float rstd = rsqrtf(ss * (1.f / 1024.f) + EPS);
    if (l == DEPTH - 1) {
#pragma unroll
        for (int i = 0; i < 4; ++i) *(f32x4*)(xr + i * 4) = xv[i] * rstd * gq[i];
    } else {
#pragma unroll
        for (int i = 0; i < 4; ++i) *(f32x4*)(xr + i * 4) = xv[i];
        u32x4 o0, o1;
#pragma unroll
        for (int i = 0; i < 4; ++i) {
            const f32x4 hq = xv[i] * rstd * gq[i] * (sc[i] + 1.f) + sh[i];
            const unsigned w0 = pack_bf16(hq[0], hq[1]), w1 = pack_bf16(hq[2], hq[3]);
            if (i < 2) { o0[2 * i] = w0; o0[2 * i + 1] = w1; } else { o1[2 * (i - 2)] = w0; o1[2 * (i - 2) + 1] = w1; }
        }
        bf16_t* hp = (bf16_t*)(p.ws() + OFF_H) + (size_t)row * D + lane * 16;
        *(u32x4*)hp = o0; *(u32x4*)(hp + 8) = o1;
    }
}
template <int NTK>
__device__ __forceinline__ void gather_item(const Ctx& p, int l, const GEnv& e, const float* modv, LAS unsigned char* glds, LAS unsigned* sl, int wid, int lane,
                                            int row0, int rstep, int ng, int gA0, int gB0) {
        constexpr bool multi = NTK > 2;
        GTok T[NTK];
        LAS float* wpark = (LAS float*)(glds + 98304) + wid * 1024 + lane;
        u32x4 h[NTK][2];
#pragma unroll
        for (int t = 0; t < NTK; ++t) { gtok_setup(T[t], e, row0 + t * rstep, lane, sl + t * 384, h[t]); wpark[(t * 2) * 64] = 0.f; wpark[(t * 2 + 1) * 64] = 0.f; __builtin_amdgcn_sched_barrier(0); }
        {
            u32x4 ua[4], ub[4];
            float pp[16];
#define U_LOAD(U, K, E0) { const int _is = (int)sl[(K) * 384 + ((E0) < 64 ? 0 : 64) + lane]; _Pragma("unroll") for (int j = 0; j < 4; ++j) U[j] = row8_load(e.PU, __builtin_amdgcn_readlane(_is, ((E0) + j) & 63), lane); }
#define U_DOT(U, T, O) { _Pragma("unroll") for (int j = 0; j < 4; ++j) { pp[(O) + j] = row8_dot(U[j], hvc); if (j & 1) __builtin_amdgcn_sched_barrier(0); } }
#define U_FLY(K, G) { const bool b5 = (lane & 32) != 0, b4 = (lane & 16) != 0, b3 = (lane & 8) != 0, b2 = (lane & 4) != 0; \
                float q8[8], q4[4], q2[2], q1; \
                _Pragma("unroll") for (int i = 0; i < 8; ++i) { const float keep = b5 ? pp[i + 8] : pp[i], send = b5 ? pp[i] : pp[i + 8]; q8[i] = keep + __shfl_xor(send, 32); } \
                _Pragma("unroll") for (int i = 0; i < 4; ++i) { const float keep = b4 ? q8[i + 4] : q8[i], send = b4 ? q8[i] : q8[i + 4]; q4[i] = keep + __shfl_xor(send, 16); } \
                _Pragma("unroll") for (int i = 0; i < 2; ++i) { const float keep = b3 ? q4[i + 2] : q4[i], send = b3 ? q4[i] : q4[i + 2]; q2[i] = keep + __shfl_xor(send, 8); } \
                { const float keep = b2 ? q2[1] : q2[0], send = b2 ? q2[0] : q2[1]; q1 = keep + __shfl_xor(send, 4); } \
                q1 += __shfl_xor(q1, 2); q1 += __shfl_xor(q1, 1); \
                const bool mine = (lane & 3) == ((G) & 3); \
                if (mine) wpark[((K) * 2 + ((G) >> 2)) * 64] = q1; }
#define U_GROUP(K, G, NEXT) { f32x2 hvc[8]; _Pragma("unroll") for (int i = 0; i < 4; ++i) { hvc[i] = (f32x2){__uint_as_float(h[K][0][i] << 16), __uint_as_float(h[K][0][i] & 0xFFFF0000u)}; \
                hvc[4 + i] = (f32x2){__uint_as_float(h[K][1][i] << 16), __uint_as_float(h[K][1][i] & 0xFFFF0000u)}; } \
                U_LOAD(ub, K, (G) * 16 + 4) __builtin_amdgcn_sched_barrier(0); U_DOT(ua, T[K], 0) __builtin_amdgcn_sched_barrier(0); \
                U_LOAD(ua, K, (G) * 16 + 8) __builtin_amdgcn_sched_barrier(0); U_DOT(ub, T[K], 4) __builtin_amdgcn_sched_barrier(0); \
                U_LOAD(ub, K, (G) * 16 + 12) __builtin_amdgcn_sched_barrier(0); U_DOT(ua, T[K], 8) __builtin_amdgcn_sched_barrier(0); \
                NEXT __builtin_amdgcn_sched_barrier(0); U_DOT(ub, T[K], 12) U_FLY(K, G) }
            U_LOAD(ua, 0, gA0 * 16)
#pragma unroll 1
            for (int gi = 0; gi < ng; ++gi) {
                const int gA = gA0 + gi, gB = gB0 + gi;
                if constexpr (!multi) {
                    U_GROUP(0, gA, U_LOAD(ua, 1, gB * 16))
                    U_GROUP(1, gB, if (gi + 1 < ng) U_LOAD(ua, 0, gA * 16 + 16))
                } else {
                    U_GROUP(0, gA, U_LOAD(ua, 1, gA * 16))
                    U_GROUP(1, gA, U_LOAD(ua, 2, gA * 16))
                    U_GROUP(2, gA, U_LOAD(ua, 3, gA * 16))
                    U_GROUP(3, gA, U_LOAD(ua, 4, gA * 16))
                    U_GROUP(4, gA, U_LOAD(ua, 5, gA * 16))
                    U_GROUP(5, gA, U_LOAD(ua, 6, gA * 16))
                    U_GROUP(6, gA, U_LOAD(ua, 7, gA * 16))
                    U_GROUP(7, gA, if (gi + 1 < ng) U_LOAD(ua, 0, gA * 16 + 16))
                }
            }
#undef U_LOAD
#undef U_DOT
#undef U_FLY
#undef U_GROUP
        }
        __builtin_amdgcn_sched_barrier(0);
#pragma unroll
        for (int t = 0; t < NTK; ++t) {
            T[t].dv[0] = wpark[(t * 2) * 64]; T[t].dv[1] = wpark[(t * 2 + 1) * 64];
            gtok_weights(T[t], lane, sl + t * 384);
            wpark[(t * 2 + 0) * 64] = T[t].W[0]; wpark[(t * 2 + 1) * 64] = T[t].W[1];
        }
        __builtin_amdgcn_sched_barrier(0);
        auto pair2 = [&](GTok& X, GTok& Y, const int rowX, const int rowY) {
            {
#pragma unroll
                for (int i = 0; i < 8; ++i) { X.o[i] = (f32x2){0.f, 0.f}; Y.o[i] = (f32x2){0.f, 0.f}; }
                u32x4 va[4], vb[4];
#define V_LOAD(V, T, E0) { const int _is = (E0) < 64 ? T.i0 : T.i1; _Pragma("unroll") for (int j = 0; j < 4; ++j) V[j] = row8_load(e.PV, __builtin_amdgcn_readlane(_is, ((E0) + j) & 63), lane); }
#define V_ACC(V, T, E0) { const float _w = (E0) < 64 ? T.W[0] : T.W[1]; _Pragma("unroll") for (int j = 0; j < 4; ++j) { const int _e = ((E0) + j) & 63; \
                row8_axpy(T.o, V[j], rl_f(_w, ((_e & 15) << 2) | (_e >> 4))); if (j & 1) __builtin_amdgcn_sched_barrier(0); } }
#define V_GROUP(T, G, NEXT) { \
                V_LOAD(vb, T, (G) * 16 + 4) __builtin_amdgcn_sched_barrier(0); V_ACC(va, T, (G) * 16) __builtin_amdgcn_sched_barrier(0); \
                V_LOAD(va, T, (G) * 16 + 8) __builtin_amdgcn_sched_barrier(0); V_ACC(vb, T, (G) * 16 + 4) __builtin_amdgcn_sched_barrier(0); \
                V_LOAD(vb, T, (G) * 16 + 12) __builtin_amdgcn_sched_barrier(0); V_ACC(va, T, (G) * 16 + 8) __builtin_amdgcn_sched_barrier(0); \
                NEXT __builtin_amdgcn_sched_barrier(0); V_ACC(vb, T, (G) * 16 + 12) }
                V_LOAD(va, X, gA0 * 16)
#pragma unroll 1
                for (int gi = 0; gi < ng; ++gi) {
                    const int gA = gA0 + gi, gB = gB0 + gi;
                    V_GROUP(X, gA, V_LOAD(va, Y, gB * 16))
                    V_GROUP(Y, gB, if (gi + 1 < ng) V_LOAD(va, X, gA * 16 + 16))
                }
#undef V_LOAD
#undef V_ACC
#undef V_GROUP
            }
            if constexpr (!multi) {
#pragma unroll
                for (int i = 0; i < 8; ++i) X.o[i] += Y.o[i];
                LAS f32x2* part = (LAS f32x2*)(glds + 98304) + (wid * 64 + lane) * 8;
#pragma unroll
                for (int i = 0; i < 8; ++i) part[i] = X.o[i];
                __syncthreads();
                if ((wid & 3) != 0) return;
#pragma unroll
                for (int q = 1; q < 4; ++q) {
                    const LAS f32x2* pq = (const LAS f32x2*)(glds + 98304) + ((wid + q) * 64 + lane) * 8;
#pragma unroll
                    for (int i = 0; i < 8; ++i) X.o[i] += pq[i];
                }
                gather_epilogue(p, l, rowX, lane, X.o, modv);
            } else {
                gather_epilogue(p, l, rowX, lane, X.o, modv);
                gather_epilogue(p, l, rowY, lane, Y.o, modv);
            }
        };
#pragma unroll 1
        for (int k = 0; k < NTK / 2; ++k) {
            asm volatile("" ::: "memory");
            __builtin_amdgcn_sched_barrier(0);
            GTok X2, Y2;
            X2.i0 = (int)sl[(2 * k) * 384 + lane]; X2.i1 = (int)sl[(2 * k) * 384 + 64 + lane]; Y2.i0 = (int)sl[(2 * k + 1) * 384 + lane]; Y2.i1 = (int)sl[(2 * k + 1) * 384 + 64 + lane];
            X2.W[0] = wpark[((2 * k) * 2 + 0) * 64]; X2.W[1] = wpark[((2 * k) * 2 + 1) * 64]; Y2.W[0] = wpark[((2 * k + 1) * 2 + 0) * 64]; Y2.W[1] = wpark[((2 * k + 1) * 2 + 1) * 64];
            pair2(X2, Y2, row0 + (2 * k) * rstep, row0 + (2 * k + 1) * rstep);
        }
    }
__device__ __forceinline__ void phase_gather(const Ctx& p, int l, LAS unsigned char* glds) {
    const int tid = tid_opaque(), lane0 = tid & 63, wid = __builtin_amdgcn_readfirstlane(tid >> 6);
    GEnv e;
    e.PU = wsw(p, l) + OFF_PU; e.PV = wsw(p, l) + OFF_PV; e.SCU = (const float*)(wsw(p, l) + OFF_SCU); e.SCV = (const float*)(wsw(p, l) + OFF_SCV);
    e.H = (const bf16_t*)(p.ws() + OFF_H); e.IDX = (const int*)(p.ws() + OFF_IDX); e.GATE = (const float*)(p.ws() + OFF_GATE);
    const float* modv = (const float*)(p.ws() + OFF_MODV) + (size_t)l * 3 * 6144;
    LAS unsigned* sl = (LAS unsigned*)glds + wid * 3072;
    const int gw = blockIdx.x * 8 + wid, nw = gridDim.x * 8;
    const bool balanced = (nw * 16 == ML) && (MC * 4 == nw);
    const int nitems = balanced ? (l < DEPTH - 1 ? 3 : 2) : 0;
#pragma unroll 1
    for (int it = 0; it < nitems; ++it) {
        int lane = lane0; asm volatile("" : "+v"(lane));
        const bool quarter = it == 2;
        xcd_soft_sync((unsigned*)(p.ws() + OFF_BAR), (volatile LAS unsigned*)(glds + XB_LDS_OFF), (unsigned)(l * 3 + it));
        const int ng = quarter ? 1 : 8, gA0 = quarter ? 2 * (gw & 3) : 0, gB0 = quarter ? gA0 + 1 : 0;
        if (quarter) gather_item<2>(p, l, e, modv, glds, sl, wid, lane, ML + (gw >> 2), 0, ng, gA0, gB0);
        else gather_item<8>(p, l, e, modv, glds, sl, wid, lane, gw + (8 * it) * nw, nw, ng, gA0, gB0);
    }
    if (!balanced) {
        const int lane = lane0;
        for (int row = gw; row < ((l < DEPTH - 1) ? M : ML); row += nw) {
            u32x4 hA[2];
            GTok A; gtok_setup(A, e, row, lane, sl, hA);
            f32x2 hvc[8];
#pragma unroll
            for (int i = 0; i < 4; ++i) { hvc[i] = (f32x2){__uint_as_float(hA[0][i] << 16), __uint_as_float(hA[0][i] & 0xFFFF0000u)}; hvc[4 + i] = (f32x2){__uint_as_float(hA[1][i] << 16), __uint_as_float(hA[1][i] & 0xFFFF0000u)}; }
#pragma unroll
            for (int i = 0; i < 8; ++i) A.o[i] = (f32x2){0.f, 0.f};
            for (int ee = 0; ee < 128; ++ee) {
                const int idx = __builtin_amdgcn_readlane(ee < 64 ? A.i0 : A.i1, ee & 63);
                const u32x4 ur = row8_load(e.PU, idx, lane), vr = row8_load(e.PV, idx, lane);
                float d = row8_dot(ur, hvc);
                d = wave_sum(d);
                const float w = __uint_as_float(sl[256 + ee]) * gelu_erf_f(__uint_as_float(sl[128 + ee]) * d);
                row8_axpy(A.o, vr, w);
            }
            gather_epilogue(p, l, row, lane, A.o, modv);
        }
    }
}

__device__ __forceinline__ void phase_copy_x(const Ctx& p) {
    const size_t n4 = (size_t)M * D / 4;
    for (size_t i = (size_t)blockIdx.x * NT + threadIdx.x; i < n4; i += (size_t)gridDim.x * NT) {
        const size_t e = i * 4;
        if (e < (size_t)ML * D) *(float4*)(p.out() + e) = *(const float4*)(p.in(I_X) + e);
        else *(float4*)((float*)(p.ws() + OFF_XC) + (e - (size_t)ML * D)) = *(const float4*)(p.in(I_CTX) + (e - (size_t)ML * D));
    }
}

__global__ void __launch_bounds__(NT, 2) fwd_kernel(Params kp) {
    extern __shared__ __attribute__((aligned(16))) unsigned char smem_raw[];
    LAS unsigned char* lds = (LAS unsigned char*)smem_raw;
    if (threadIdx.x == 0) *(LAS u32x4*)(lds + XB_LDS_OFF) = (u32x4){0u, 0u, 0u, 0u};
    __syncthreads();
    XcdBarrier bar = xcd_barrier_post((unsigned*)(kp.ws + OFF_BAR), (volatile LAS unsigned*)(lds + XB_LDS_OFF));
#ifdef LDS_PROBE
    {
        volatile LAS unsigned* hi = (volatile LAS unsigned*)(lds + 90000);
        if (threadIdx.x == 0) *hi = 0xABCD1234u;
        __syncthreads();
        if (threadIdx.x == 64) { const unsigned rb = *hi; if (rb != 0xABCD1234u) atomicAdd((unsigned*)(kp.ws + OFF_BAR) + 8, 1u); }
        __syncthreads();
    }
#endif

#define GRID_BARRIER() do { XcdBarrier _b = bar; asm volatile("" : "+s"(_b.bar), "+s"(_b.x)); xcd_barrier(_b); } while (0)
#ifndef PMASK
#define PMASK 0xFFFF
#endif
#ifndef REPMASK
#define REPMASK 0
#endif
#define RUN(bit, call) do { if (PMASK & (bit)) { int _reps = (REPMASK & (bit)) ? 2 : 1; if (REPMASK) asm volatile("" : "+s"(_reps)); _Pragma("unroll 1") for (int _r = 0; _r < _reps; ++_r) { call; } } } while (0)
    RUN(1, phase_modv(get_ctx(), lds));
    RUN(2, phase_prep(get_ctx(), 0, 128, lds));
    GRID_BARRIER();
    RUN(4, phase_norm(get_ctx(), 0, 0));
    GRID_BARRIER();
    for (int l = 0; l < DEPTH; ++l) {
        RUN(64, phase_g1(get_ctx(), l, lds));
        GRID_BARRIER();
        RUN(128, phase_x1(get_ctx(), l, lds));
        GRID_BARRIER();
        RUN(256, phase_x2(get_ctx(), l, lds));
        if (l + 1 < DEPTH) { RUN(2, phase_prep(get_ctx(), l + 1, 128, lds)); }
        GRID_BARRIER();
        RUN(512, phase_x3(get_ctx(), l, lds));
        GRID_BARRIER();
        RUN(1024, phase_g2(get_ctx(), l, lds));
        GRID_BARRIER();
        if (PMASK & 2048) phase_g3(get_ctx(), l, lds);
        GRID_BARRIER();
        if (PMASK & 4096) phase_g4(get_ctx(), l, lds);
        GRID_BARRIER();
        RUN(4, phase_norm(get_ctx(), l, 1));
        GRID_BARRIER();
        RUN(8, phase_g5(get_ctx(), l, lds));
        GRID_BARRIER();
        RUN(16, phase_select(get_ctx(), l, lds));
        GRID_BARRIER();
        if (PMASK & 32) phase_gather(get_ctx(), l, lds);
        GRID_BARRIER();
    }
}

extern "C" void kernel_launch(void* const* d_in, const int* in_sizes, int n_in, void* d_out, int out_size, void* d_ws, size_t ws_size,
                              hipStream_t stream) {
    static int grid = 0;
    if (!grid) {
        int dev = 0, cus = 0, per_cu = 0;
        (void)hipGetDevice(&dev);
        if (hipDeviceGetAttribute(&cus, hipDeviceAttributeMultiprocessorCount, dev) != hipSuccess || cus <= 0) cus = 256;
        if (hipFuncSetAttribute((const void*)fwd_kernel, hipFuncAttributeMaxDynamicSharedMemorySize, LDS_BYTES) != hipSuccess)
            fprintf(stderr, "kernel_launch: hipFuncSetAttribute failed\n");
        if (hipOccupancyMaxActiveBlocksPerMultiprocessor(&per_cu, (const void*)fwd_kernel, NT, LDS_BYTES) != hipSuccess || per_cu < 1)
            fprintf(stderr, "kernel_launch: note: occupancy query reports %d workgroups per CU\n", per_cu);
        (void)hipGetLastError();
        grid = 256;
        if (cus != 256) fprintf(stderr, "kernel_launch: note: device reports %d CUs; the kernel is laid out for 256\n", cus);
        if (ws_size < WS_TOTAL) fprintf(stderr, "kernel_launch: workspace too small: %zu < %zu\n", ws_size, (size_t)WS_TOTAL);
    }
    (void)hipMemsetAsync((unsigned char*)d_ws + OFF_BAR, 0, 16384, stream);
    Params p{};
    for (int i = 0; i < 30; ++i) p.in[i] = (const float*)d_in[i];
    p.out = (float*)d_out; p.ws = (unsigned char*)d_ws;
    fwd_kernel<<<dim3(grid), dim3(NT), LDS_BYTES, stream>>>(p);
}
```
